# Optimizing an MI355X kernel written in HIP

```python
import jax, jax.numpy as jnp
from jax import lax
import numpy as np

D_MODEL = 1024
BATCH = 16
SEQ = 2048
DEPTH = 1

MEM_LEN = 256
HEAD_DIM = 64
SB_HEADS = 8
RWKV_HEADS = 8
SB_WIDTH = SB_HEADS * HEAD_DIM
RWKV_WIDTH = RWKV_HEADS * HEAD_DIM
MIX_WIDTH = SB_WIDTH + RWKV_WIDTH
DECAY_LORA = 64
AAA_LORA = 64
GATE_LORA = 160
RWKV_IN = 3 * RWKV_WIDTH + DECAY_LORA + AAA_LORA + GATE_LORA
MIX_IN = 3 * SB_WIDTH + RWKV_IN
MEM_HEADS = 4
MEM_HEAD_DIM = 128
MEM_WIDTH = MEM_HEADS * MEM_HEAD_DIM
D_FF = 2816
SB_BLOCK = 128
NORM_EPS = 1e-6
LNX_EPS = 64e-5
RWKV_SPLITS = [RWKV_WIDTH, 2 * RWKV_WIDTH, 3 * RWKV_WIDTH,
               3 * RWKV_WIDTH + DECAY_LORA, 3 * RWKV_WIDTH + DECAY_LORA + AAA_LORA]

kernel_name = 'sb_rwkv7_macaron_sandwich_hybrid'


def rms_norm(x, g):
    xf = x.astype(jnp.float32)
    y = xf * lax.rsqrt(jnp.mean(xf * xf, axis=-1, keepdims=True) + NORM_EPS)
    return (y * g.astype(jnp.float32)).astype(x.dtype)


def swiglu(h, w_in, w_out):
    gate, up = jnp.split(h @ w_in, 2, axis=-1)
    return (jax.nn.silu(gate) * up) @ w_out


def token_shift(p):
    return jnp.pad(p, ((0, 0), (1, 0), (0, 0)))[:, :-1]


def stick_breaking_attention(q, k, v):
    S = q.shape[1]
    scale = q.shape[-1] ** -0.5
    outs = []
    for blk in range(S // SB_BLOCK):
        q0 = blk * SB_BLOCK
        q1 = q0 + SB_BLOCK
        z = jnp.einsum('bthd,bshd->bhts', q[:, q0:q1], k[:, :q1]).astype(jnp.float32) * scale
        causal = jnp.arange(q1)[None, :] < (q0 + jnp.arange(SB_BLOCK))[:, None]
        log_one_minus = jnp.where(causal, jax.nn.log_sigmoid(-z), 0.0)
        log_tail = lax.cumsum(log_one_minus, axis=3, reverse=True) - log_one_minus
        a = jnp.where(causal, jnp.exp(jax.nn.log_sigmoid(z) + log_tail), 0.0)
        outs.append(jnp.einsum('bhts,bshd->bthd', a.astype(v.dtype), v[:, :q1]))
    return jnp.concatenate(outs, axis=1)


def rwkv7_time_mix(p, mu, w0, w2, a0, a2, g2, k_k, k_a, r_k, lnx_g, lnx_b):
    B, S, _ = p.shape
    H, N = RWKV_HEADS, HEAD_DIM
    p = p + (token_shift(p) - p) * mu
    r, k, v, xw, xa, xg = jnp.split(p, RWKV_SPLITS, axis=-1)
    w = -jax.nn.softplus(-(w0 + jnp.tanh(xw) @ w2)) - 0.5
    decay = jnp.exp(-jnp.exp(w.astype(jnp.float32)))
    a = jax.nn.sigmoid(a0 + xa @ a2)
    g = jax.nn.sigmoid(xg) @ g2
    heads = lambda t: t.reshape(B, S, H, N)
    kk = heads(k * k_k).astype(jnp.float32)
    kk = kk / jnp.maximum(jnp.linalg.norm(kk, axis=-1, keepdims=True), 1e-12)
    k = k * (1.0 + (a - 1.0) * k_a)
    rh, kh, vh, ah = heads(r), heads(k), heads(v), heads(a)
    seq_first = lambda t: jnp.moveaxis(t.astype(jnp.float32), 1, 0)
    xs = (seq_first(rh), seq_first(heads(decay)), seq_first(kh), seq_first(vh),
          seq_first(-kk), seq_first(kk * ah))

    def step(state, inp):
        r_t, w_t, k_t, v_t, a_t, b_t = inp
        sa = jnp.einsum('bhvk,bhk->bhv', state, a_t)
        state = (state * w_t[:, :, None, :] + sa[..., :, None] * b_t[..., None, :]
                 + v_t[..., :, None] * k_t[..., None, :])
        return state, jnp.einsum('bhvk,bhk->bhv', state, r_t)

    state0 = jnp.zeros((B, H, N, N), jnp.float32)
    _, y = lax.scan(step, state0, xs)
    y = jnp.moveaxis(y, 0, 1)
    mean = jnp.mean(y, axis=-1, keepdims=True)
    var = jnp.mean(jnp.square(y - mean), axis=-1, keepdims=True)
    y = (y - mean) * lax.rsqrt(var + LNX_EPS)
    y = y * lnx_g.astype(jnp.float32).reshape(H, N) + lnx_b.astype(jnp.float32).reshape(H, N)
    bonus = jnp.sum((rh * kh * r_k).astype(jnp.float32), axis=-1, keepdims=True) * vh.astype(jnp.float32)
    return (y + bonus).reshape(B, S, RWKV_WIDTH).astype(p.dtype) * g


def memory_cross_attention(h, mem_n, w_q, w_kv, w_o):
    B, S, _ = h.shape
    M = mem_n.shape[1]
    q = (h @ w_q).reshape(B, S, MEM_HEADS, MEM_HEAD_DIM)
    km, vm = jnp.split(mem_n @ w_kv, 2, axis=-1)
    km = km.reshape(B, M, MEM_HEADS, MEM_HEAD_DIM)
    vm = vm.reshape(B, M, MEM_HEADS, MEM_HEAD_DIM)
    s = jnp.einsum('bthd,bmhd->bhtm', q, km).astype(jnp.float32) * (MEM_HEAD_DIM ** -0.5)
    pr = jax.nn.softmax(s, axis=-1)
    o = jnp.einsum('bhtm,bmhd->bthd', pr.astype(vm.dtype), vm).reshape(B, S, MEM_WIDTH)
    return o @ w_o


def setup_inputs(seed: int = 0) -> dict:
    key = jax.random.key(seed)
    ks = jax.random.split(key, 32)
    L = DEPTH

    def nrm(k, shape, scale):
        return jax.random.normal(k, shape, jnp.float32) * scale

    def gain(k, n):
        return 1.0 + nrm(k, (L, n), 0.02)

    pos = jnp.arange(RWKV_WIDTH, dtype=jnp.float32) / (RWKV_WIDTH - 1)
    w0_base = -6.5 + 5.0 * pos ** 0.85
    return {
        'x': nrm(ks[0], (BATCH, SEQ, D_MODEL), 1.0),
        'mem': nrm(ks[1], (BATCH, MEM_LEN, D_MODEL), 1.0),
        'ffn1_pre': gain(ks[2], D_MODEL),
        'ffn1_post': gain(ks[3], D_MODEL),
        'ffn1_w_in': nrm(ks[4], (L, D_MODEL, 2 * D_FF), D_MODEL ** -0.5),
        'ffn1_w_out': nrm(ks[5], (L, D_FF, D_MODEL), D_FF ** -0.5),
        'mix_pre': gain(ks[6], D_MODEL),
        'mix_post': gain(ks[7], D_MODEL),
        'mix_w_in': nrm(ks[8], (L, D_MODEL, MIX_IN), D_MODEL ** -0.5),
        'rwkv_mu': jax.random.uniform(ks[9], (L, RWKV_IN), jnp.float32),
        'rwkv_w0': w0_base[None, :] + nrm(ks[10], (L, RWKV_WIDTH), 0.01),
        'rwkv_w2': nrm(ks[11], (L, DECAY_LORA, RWKV_WIDTH), 0.1 * DECAY_LORA ** -0.5),
        'rwkv_a0': nrm(ks[12], (L, RWKV_WIDTH), 0.1),
        'rwkv_a2': nrm(ks[13], (L, AAA_LORA, RWKV_WIDTH), 0.1 * AAA_LORA ** -0.5),
        'rwkv_g2': nrm(ks[14], (L, GATE_LORA, RWKV_WIDTH), GATE_LORA ** -0.5),
        'rwkv_k_k': 0.85 + nrm(ks[15], (L, RWKV_WIDTH), 0.02),
        'rwkv_k_a': 1.0 + nrm(ks[16], (L, RWKV_WIDTH), 0.02),
        'rwkv_r_k': nrm(ks[17], (L, RWKV_HEADS, HEAD_DIM), 0.1),
        'rwkv_lnx_g': gain(ks[18], RWKV_WIDTH),
        'rwkv_lnx_b': nrm(ks[19], (L, RWKV_WIDTH), 0.02),
        'sb_out_g': gain(ks[20], SB_WIDTH),
        'mix_w_out': nrm(ks[21], (L, MIX_WIDTH, D_MODEL), MIX_WIDTH ** -0.5),
        'mem_pre': gain(ks[22], D_MODEL),
        'mem_post': gain(ks[23], D_MODEL),
        'mem_kv_g': gain(ks[24], D_MODEL),
        'mem_w_q': nrm(ks[25], (L, D_MODEL, MEM_WIDTH), D_MODEL ** -0.5),
        'mem_w_kv': nrm(ks[26], (L, D_MODEL, 2 * MEM_WIDTH), D_MODEL ** -0.5),
        'mem_w_o': nrm(ks[27], (L, MEM_WIDTH, D_MODEL), MEM_WIDTH ** -0.5),
        'ffn2_pre': gain(ks[28], D_MODEL),
        'ffn2_post': gain(ks[29], D_MODEL),
        'ffn2_w_in': nrm(ks[30], (L, D_MODEL, 2 * D_FF), D_MODEL ** -0.5),
        'ffn2_w_out': nrm(ks[31], (L, D_FF, D_MODEL), D_FF ** -0.5),
    }


def reference(x, mem, ffn1_pre, ffn1_post, ffn1_w_in, ffn1_w_out, mix_pre, mix_post, mix_w_in,
              rwkv_mu, rwkv_w0, rwkv_w2, rwkv_a0, rwkv_a2, rwkv_g2, rwkv_k_k, rwkv_k_a, rwkv_r_k,
              rwkv_lnx_g, rwkv_lnx_b, sb_out_g, mix_w_out, mem_pre, mem_post, mem_kv_g,
              mem_w_q, mem_w_kv, mem_w_o, ffn2_pre, ffn2_post, ffn2_w_in, ffn2_w_out):
    B, S, _ = x.shape
    h = x
    for l in range(DEPTH):
        h = h + 0.5 * rms_norm(swiglu(rms_norm(h, ffn1_pre[l]), ffn1_w_in[l], ffn1_w_out[l]), ffn1_post[l])

        u = rms_norm(h, mix_pre[l]) @ mix_w_in[l]
        sb_part, rw_part = jnp.split(u, [3 * SB_WIDTH], axis=-1)
        q, k, v = [t.reshape(B, S, SB_HEADS, HEAD_DIM) for t in jnp.split(sb_part, 3, axis=-1)]
        sb_o = stick_breaking_attention(q, k, v)
        sb_o = rms_norm(sb_o, sb_out_g[l].reshape(SB_HEADS, HEAD_DIM)).reshape(B, S, SB_WIDTH)
        rw_o = rwkv7_time_mix(rw_part, rwkv_mu[l], rwkv_w0[l], rwkv_w2[l], rwkv_a0[l], rwkv_a2[l],
                              rwkv_g2[l], rwkv_k_k[l], rwkv_k_a[l], rwkv_r_k[l],
                              rwkv_lnx_g[l], rwkv_lnx_b[l])
        mixed = jnp.concatenate([sb_o, rw_o], axis=-1) @ mix_w_out[l]
        h = h + rms_norm(mixed, mix_post[l])

        mem_n = rms_norm(mem, mem_kv_g[l])
        m_o = memory_cross_attention(rms_norm(h, mem_pre[l]), mem_n, mem_w_q[l], mem_w_kv[l], mem_w_o[l])
        h = h + rms_norm(m_o, mem_post[l])

        h = h + 0.5 * rms_norm(swiglu(rms_norm(h, ffn2_pre[l]), ffn2_w_in[l], ffn2_w_out[l]), ffn2_post[l])
    return h
```

```cpp
#include <hip/hip_runtime.h>
#include <hip/hip_cooperative_groups.h>
#include <cstdio>
#include <cstdint>
namespace cg = cooperative_groups;
namespace pg8 {
#define PG8_LAS __attribute__((address_space(3)))
typedef unsigned short bf16_t;
typedef short bf16x8 __attribute__((ext_vector_type(8)));
typedef float f32x4 __attribute__((ext_vector_type(4)));
typedef unsigned u32x4 __attribute__((ext_vector_type(4)));
constexpr int BM = 256, BK = 64, HALF = 128, HTB = HALF * BK * 2  , STAGE_BYTES = 8 * HTB, NXCD = 8, WGM = 8;

__host__ __device__ __forceinline__ int lds_byte(int r, int c) { const int st = (r >> 4) * 2 + (c >> 5), rr = r & 15, cc = c & 31, ob = rr * 64 + cc * 2; return st * 1024 + (ob ^ (((ob >> 9) & 1) << 5)); }
__host__ __device__ __forceinline__ void stage_rc(int b, int& R, int& C) { const int st = b / 1024, sb = b % 1024, swz = sb ^ (((sb >> 9) & 1) << 5); R = (st >> 1) * 16 + swz / 64; C = (st & 1) * 32 + (swz % 64) / 2; }
__host__ __device__ __forceinline__ int perm32(int rho) { const int n = rho >> 4, i = rho & 15; return 8 * (i >> 2) + 4 * n + (i & 3); }

struct Unit { int pm, pn; };
struct Gemm { const bf16_t* A; const bf16_t* Bt; int M, N, K; };

struct StaticOrder {
    int nM, nN, nwg, G, c;
    __host__ __device__ void init(int M, int N, int G_, int c_) { nM = M / BM; nN = N / BM; nwg = nM * nN; G = G_; c = c_; }
    __host__ __device__ bool next(int i, Unit& u) const {
        const long L = (long)i * G + c; if (L >= nwg) return false;
        int wgid = (int)L; { const int q = nwg / NXCD, r = nwg % NXCD, xcd = wgid % NXCD, off = wgid / NXCD; wgid = (xcd < r ? xcd * (q + 1) : r * (q + 1) + (xcd - r) * q) + off; }
        const int nig = WGM * nN, gid = wgid / nig, fm = gid * WGM, gsz = (nM - fm) < WGM ? (nM - fm) : WGM;
        u.pm = fm + ((wgid % nig) % gsz); u.pn = (wgid % nig) / gsz; return true;
    }
    __device__ __forceinline__ void a_ready(const Unit&) const {}
    __device__ __forceinline__ void done(const Unit&) const {}
};
__device__ __forceinline__ unsigned cvt_pk_bf16(float lo, float hi) { unsigned r; asm volatile("v_cvt_pk_bf16_f32 %0, %1, %2" : "=v"(r) : "v"(lo), "v"(hi)); return r; }
typedef float f32x2 __attribute__((ext_vector_type(2)));
struct EpiU {
    static constexpr bool PERM = true, AFTER_DRAIN = false;
    bf16_t* O; int ldc; int mode;
    __device__ __forceinline__ void operator()(const f32x4 (&acc)[2][2][4][2], const Unit& u, int wr, int wc, int fr, int fq) const {
        const int row0 = u.pm * BM + wr * 64 + fr;
        if (mode == 0) {
            const int col0 = u.pn * BM + wc * 32 + 8 * fq;
#pragma unroll
            for (int ai = 0; ai < 2; ++ai)
#pragma unroll
                for (int m = 0; m < 4; ++m) { bf16_t* rowp = O + (size_t)(row0 + ai * HALF + m * 16) * ldc + col0;
#pragma unroll
                    for (int bj = 0; bj < 2; ++bj) { const f32x4 v0 = acc[ai][bj][m][0], v1 = acc[ai][bj][m][1];
                        u32x4 w; w.x = cvt_pk_bf16(v0[0], v0[1]); w.y = cvt_pk_bf16(v0[2], v0[3]); w.z = cvt_pk_bf16(v1[0], v1[1]); w.w = cvt_pk_bf16(v1[2], v1[3]);
                        *(u32x4*)(rowp + bj * HALF) = w; } }
        } else {
            const int col0 = u.pn * HALF + wc * 32 + 8 * fq;
#pragma unroll
            for (int ai = 0; ai < 2; ++ai)
#pragma unroll
                for (int m = 0; m < 4; ++m) { bf16_t* rowp = O + (size_t)(row0 + ai * HALF + m * 16) * ldc + col0;
                    float hv[8];
#pragma unroll
                    for (int n = 0; n < 2; ++n)
#pragma unroll
                        for (int j = 0; j < 4; ++j) { const float g = acc[ai][0][m][n][j], up = acc[ai][1][m][n][j];
                            hv[4 * n + j] = g * __builtin_amdgcn_rcpf(1.f + __expf(-g)) * up; }
                    u32x4 w; w.x = cvt_pk_bf16(hv[0], hv[1]); w.y = cvt_pk_bf16(hv[2], hv[3]); w.z = cvt_pk_bf16(hv[4], hv[5]); w.w = cvt_pk_bf16(hv[6], hv[7]);
                    *(u32x4*)rowp = w; }
        }
    }
};
template <class Epi, class Sched, bool ALIGN_EPI = false, bool SP2 = false>
__device__ __forceinline__ void gemm_phase(PG8_LAS unsigned char* lds, const Gemm g, const Sched& S, const Epi& E, const int tid) {
    const int wid = __builtin_amdgcn_readfirstlane(tid >> 6), lane = tid & 63, wr = wid >> 2, wc = wid & 3, fr = lane & 15, fq = lane >> 4;
    const int K = g.K, nt = K / BK;
    unsigned voffA[2], voffB[2];
#pragma unroll
    for (int i = 0; i < 2; ++i) { int R, C; stage_rc(tid * 16 + i * 8192, R, C); const int Rb = Epi::PERM ? ((R & ~31) + perm32(R & 31)) : R;
        voffA[i] = (unsigned)(R * K + C) * 2u; voffB[i] = (unsigned)(Rb * K + C) * 2u; }
    const size_t kstep = (size_t)(BK * 2);
    const size_t hstep = (size_t)HALF * K * 2;
    const size_t tstep = 2 * hstep;
    const unsigned ldsw = (unsigned)wid * 1024u;
    const int aoff = lds_byte(wr * 64 + fr, fq * 8), boff = lds_byte(wc * 32 + fr, fq * 8);
#define PG8_SA(b, h) (((b) * 2 + (h)) * HTB)
#define PG8_SB(b, h) ((4 + (b) * 2 + (h)) * HTB)
#define PG8_STAGE(bufoff, gbase, voff) do { _Pragma("unroll") for (int _i = 0; _i < 2; ++_i) \
        __builtin_amdgcn_global_load_lds((const unsigned*)((const char*)(gbase) + (voff)[_i]), (PG8_LAS unsigned*)(lds + (bufoff) + ldsw + _i * 8192), 16, 0, 0); } while (0)
#define PG8_LDA(dst, b, h) do { _Pragma("unroll") for (int m = 0; m < 4; ++m) _Pragma("unroll") for (int k = 0; k < 2; ++k) dst[m][k] = *(const PG8_LAS bf16x8*)(lds + PG8_SA(b, h) + aoff + m * 2048 + k * 1024); } while (0)
#define PG8_LDB(dst, b, h) do { _Pragma("unroll") for (int n = 0; n < 2; ++n) _Pragma("unroll") for (int k = 0; k < 2; ++k) dst[n][k] = *(const PG8_LAS bf16x8*)(lds + PG8_SB(b, h) + boff + n * 2048 + k * 1024); } while (0)
#define PG8_MMA(ai, bj, At, Bt) do { __builtin_amdgcn_s_setprio(1); _Pragma("unroll") for (int m = 0; m < 4; ++m) _Pragma("unroll") for (int n = 0; n < 2; ++n) _Pragma("unroll") for (int k = 0; k < 2; ++k) \
        acc[ai][bj][m][n] = __builtin_amdgcn_mfma_f32_16x16x32_bf16(Bt[n][k], At[m][k], acc[ai][bj][m][n], 0, 0, 0); __builtin_amdgcn_s_setprio(0); } while (0)
#define PG8_WAIT_V(n) asm volatile("s_waitcnt vmcnt(" #n ")" ::: "memory")
#define PG8_WAIT_L(n) asm volatile("s_waitcnt lgkmcnt(" #n ")" ::: "memory")
#define PG8_BAR __builtin_amdgcn_s_barrier()
#define PG8_SCHED __builtin_amdgcn_sched_barrier(0)
    Unit cur, nxt; int ui = 0;
    if (!S.next(0, cur)) return;
    f32x4 acc[2][2][4][2];
#pragma unroll
    for (int a = 0; a < 2; ++a)
#pragma unroll
        for (int b = 0; b < 2; ++b)
#pragma unroll
            for (int m = 0; m < 4; ++m)
#pragma unroll
                for (int n = 0; n < 2; ++n) acc[a][b][m][n] = (f32x4){0.f, 0.f, 0.f, 0.f};
    bf16x8 At[4][2], B0[2][2], B1[2][2];
    const char* cA = (const char*)g.A + (size_t)cur.pm * tstep; const char* cB = (const char*)g.Bt + (size_t)cur.pn * tstep;
    S.a_ready(cur);
    if constexpr (SP2) {
        PG8_STAGE(PG8_SB(0, 0), cB, voffB); PG8_STAGE(PG8_SB(0, 1), cB + hstep, voffB); PG8_STAGE(PG8_SA(0, 0), cA, voffA); PG8_STAGE(PG8_SA(0, 1), cA + hstep, voffA);
        if (wr == 1) PG8_BAR;
        PG8_WAIT_V(2); PG8_BAR;
        PG8_STAGE(PG8_SB(1, 0), cB + kstep, voffB); PG8_STAGE(PG8_SA(1, 0), cA + kstep, voffA); PG8_STAGE(PG8_SB(1, 1), cB + hstep + kstep, voffB);
        PG8_WAIT_V(6); PG8_BAR;
    } else {
        PG8_STAGE(PG8_SB(0, 0), cB, voffB); PG8_STAGE(PG8_SA(0, 0), cA, voffA); PG8_STAGE(PG8_SB(0, 1), cB + hstep, voffB); PG8_STAGE(PG8_SA(0, 1), cA + hstep, voffA);
        if (wr == 1) PG8_BAR;
        PG8_WAIT_V(4); PG8_BAR;
        PG8_STAGE(PG8_SB(1, 0), cB + kstep, voffB); PG8_STAGE(PG8_SA(1, 0), cA + kstep, voffA); PG8_STAGE(PG8_SB(1, 1), cB + hstep + kstep, voffB);
        PG8_WAIT_V(6); PG8_BAR;
    }
    for (;;) {
        const bool has_next = S.next(ui + 1, nxt);
        const char* nA = has_next ? (const char*)g.A + (size_t)nxt.pm * tstep : cA; const char* nB = has_next ? (const char*)g.Bt + (size_t)nxt.pn * tstep : cB;
        for (int t = 0; t < nt; t += 2) {
            const bool last = (t == nt - 2);
            const char* a1 = cA + (size_t)(t + 1) * kstep;
            const char* a2 = last ? nA : cA + (size_t)(t + 2) * kstep; const char* b2 = last ? nB : cB + (size_t)(t + 2) * kstep;
            const char* a3 = a2 + kstep; const char* b3 = b2 + kstep;
            if (last && has_next) S.a_ready(nxt);
            if constexpr (SP2) {
            PG8_LDB(B0, 0, 0); PG8_LDB(B1, 0, 1); PG8_SCHED; PG8_LDA(At, 0, 0); PG8_STAGE(PG8_SA(1, 1), a1 + hstep, voffA);
            PG8_WAIT_V(8); PG8_WAIT_L(0); PG8_BAR; PG8_MMA(0, 0, At, B0); PG8_MMA(0, 1, At, B1); PG8_BAR; PG8_SCHED;
            PG8_LDA(At, 0, 1); PG8_STAGE(PG8_SB(0, 0), b2, voffB); PG8_STAGE(PG8_SB(0, 1), b2 + hstep, voffB); PG8_STAGE(PG8_SA(0, 0), a2, voffA);
            PG8_WAIT_V(8); PG8_WAIT_L(0); PG8_BAR; PG8_MMA(1, 0, At, B0); PG8_MMA(1, 1, At, B1); PG8_BAR; PG8_SCHED;
            PG8_LDB(B0, 1, 0); PG8_LDB(B1, 1, 1); PG8_SCHED; PG8_LDA(At, 1, 0); PG8_STAGE(PG8_SA(0, 1), a2 + hstep, voffA);
            PG8_WAIT_V(8); PG8_WAIT_L(0); PG8_BAR; PG8_MMA(0, 0, At, B0); PG8_MMA(0, 1, At, B1); PG8_BAR; PG8_SCHED;
            PG8_LDA(At, 1, 1); PG8_STAGE(PG8_SB(1, 0), b3, voffB); PG8_STAGE(PG8_SB(1, 1), b3 + hstep, voffB); PG8_STAGE(PG8_SA(1, 0), a3, voffA);
            PG8_WAIT_V(8); PG8_WAIT_L(0); PG8_BAR; PG8_MMA(1, 0, At, B0); PG8_MMA(1, 1, At, B1); PG8_BAR; PG8_SCHED;
            } else {
            PG8_LDB(B0, 0, 0); PG8_SCHED; PG8_LDA(At, 0, 0); PG8_STAGE(PG8_SA(1, 1), a1 + hstep, voffA);
            PG8_WAIT_L(8); PG8_BAR; PG8_WAIT_L(0); PG8_MMA(0, 0, At, B0); PG8_BAR; PG8_SCHED;
            PG8_LDB(B1, 0, 1); PG8_STAGE(PG8_SB(0, 0), b2, voffB);
            PG8_BAR; PG8_WAIT_L(0); PG8_MMA(0, 1, At, B1); PG8_BAR;
            PG8_LDA(At, 0, 1); PG8_STAGE(PG8_SA(0, 0), a2, voffA);
            PG8_BAR; PG8_WAIT_L(0); PG8_MMA(1, 0, At, B0); PG8_BAR; PG8_SCHED;
            PG8_STAGE(PG8_SB(0, 1), b2 + hstep, voffB);
            PG8_WAIT_V(6); PG8_BAR; PG8_MMA(1, 1, At, B1); PG8_BAR;
            PG8_LDB(B0, 1, 0); PG8_SCHED; PG8_LDA(At, 1, 0); PG8_STAGE(PG8_SA(0, 1), a2 + hstep, voffA);
            PG8_WAIT_L(8); PG8_BAR; PG8_WAIT_L(0); PG8_MMA(0, 0, At, B0); PG8_BAR; PG8_SCHED;
            PG8_LDB(B1, 1, 1); PG8_STAGE(PG8_SB(1, 0), b3, voffB);
            PG8_BAR; PG8_WAIT_L(0); PG8_MMA(0, 1, At, B1); PG8_BAR;
            PG8_LDA(At, 1, 1); PG8_STAGE(PG8_SA(1, 0), a3, voffA);
            PG8_BAR; PG8_WAIT_L(0); PG8_MMA(1, 0, At, B0); PG8_BAR; PG8_SCHED;
            PG8_STAGE(PG8_SB(1, 1), b3 + hstep, voffB);
            PG8_WAIT_V(6); PG8_BAR; PG8_MMA(1, 1, At, B1); PG8_BAR;
            }
        }
        if constexpr (ALIGN_EPI) { if (wr == 0) PG8_BAR; }
        if constexpr (!Epi::AFTER_DRAIN) { E(acc, cur, wr, wc, fr, fq); S.done(cur); }
        if (!has_next) break;
#pragma unroll
        for (int a = 0; a < 2; ++a)
#pragma unroll
            for (int b = 0; b < 2; ++b)
#pragma unroll
                for (int m = 0; m < 4; ++m)
#pragma unroll
                    for (int n = 0; n < 2; ++n) acc[a][b][m][n] = (f32x4){0.f, 0.f, 0.f, 0.f};
        cur = nxt; cA = nA; cB = nB; ++ui;
        if constexpr (ALIGN_EPI) { if (wr == 1) PG8_BAR; }
    }
    PG8_WAIT_V(0);
    if constexpr (!ALIGN_EPI) { if (wr == 0) PG8_BAR; }
    PG8_BAR;
    if constexpr (Epi::AFTER_DRAIN) { E.fused(acc, cur, wr, wc, fr, fq, lds, wid, lane); S.done(cur); }
#undef PG8_SA
#undef PG8_SB
#undef PG8_STAGE
#undef PG8_LDA
#undef PG8_LDB
#undef PG8_MMA
#undef PG8_WAIT_V
#undef PG8_WAIT_L
#undef PG8_BAR
#undef PG8_SCHED
}
}

constexpr int D_MODEL = 1024, BATCH = 16, SEQ = 2048, M_TOK = BATCH * SEQ;
constexpr int MEM_LEN = 256, M_MEM = BATCH * MEM_LEN;
constexpr int D_FF = 2816, MIX_IN = 3360, LDU = 3584, RW_OFF = 1536, RWKV_IN = 1824;
constexpr int MEM_W = 512;
constexpr float NORM_EPS = 1e-6f, LNX_EPS = 64e-5f;
constexpr int NWAVES = 8, NTHREADS = 512;
constexpr int LDS_BYTES = 147456;
enum { I_X = 0, I_MEM, I_F1PRE, I_F1POST, I_F1WIN, I_F1WOUT, I_MIXPRE, I_MIXPOST, I_MIXWIN, I_MU, I_W0, I_W2, I_A0, I_A2, I_G2, I_KK, I_KA, I_RK, I_LNG, I_LNB,
       I_SBG, I_MIXWOUT, I_MEMPRE, I_MEMPOST, I_MEMKVG, I_WQ, I_WKV, I_WO, I_F2PRE, I_F2POST, I_F2WIN, I_F2WOUT, N_IN };
constexpr size_t MiB = 1u << 20;
constexpr size_t WS_W1IN = 2 * MiB, WS_W1OUT = 13 * MiB, WS_WMIXIN = 19 * MiB, WS_WMIXOUT = 26 * MiB, WS_WQ = 28 * MiB, WS_WKV = 29 * MiB, WS_WO = 31 * MiB,
                 WS_W2IN = 32 * MiB, WS_W2OUT = 43 * MiB, WS_LW2 = 49 * MiB, WS_LA2 = WS_LW2 + 65536, WS_LG2 = WS_LA2 + 65536,
                 WS_MEMN = 56 * MiB, WS_KVM = 64 * MiB, WS_XN = 72 * MiB, WS_Y = 136 * MiB, WS_HU = 200 * MiB, WS_HB = 424 * MiB, WS_END = 488 * MiB;
constexpr size_t WS_QM = WS_HU, WS_OM = WS_HU + 32 * MiB;

#define LAS __attribute__((address_space(3)))
typedef unsigned short bf16;
typedef short bf16x8 __attribute__((ext_vector_type(8)));
typedef short s16x4 __attribute__((ext_vector_type(4)));
typedef float f32x4 __attribute__((ext_vector_type(4)));
typedef float f32x2 __attribute__((ext_vector_type(2)));
typedef float f32x16 __attribute__((ext_vector_type(16)));
typedef unsigned u32x4 __attribute__((ext_vector_type(4)));
typedef unsigned u32x2 __attribute__((ext_vector_type(2)));

__device__ __forceinline__ float bflo(unsigned u) { return __uint_as_float(u << 16); }
__device__ __forceinline__ float bfhi(unsigned u) { return __uint_as_float(u & 0xffff0000u); }
__device__ __forceinline__ unsigned pk2(float lo, float hi) { return pg8::cvt_pk_bf16(lo, hi); }
template <int CTRL> __device__ __forceinline__ float dppf(float x) { return __builtin_bit_cast(float, __builtin_amdgcn_mov_dpp(__builtin_bit_cast(int, x), CTRL, 0xf, 0xf, true)); }
__device__ __forceinline__ float red16(float x) { x += dppf<0xB1>(x); x += dppf<0x4E>(x); x += dppf<0x141>(x); x += dppf<0x140>(x); return x; }
__device__ __forceinline__ float half_sum(float x) { auto t = __builtin_amdgcn_permlane32_swap(__float_as_uint(x), __float_as_uint(x), false, false); return __uint_as_float(t[0]) + __uint_as_float(t[1]); }
__device__ __forceinline__ float half_max(float x) { auto t = __builtin_amdgcn_permlane32_swap(__float_as_uint(x), __float_as_uint(x), false, false); return fmaxf(__uint_as_float(t[0]), __uint_as_float(t[1])); }
__device__ __forceinline__ float half_other(float x, int hi) { auto t = __builtin_amdgcn_permlane32_swap(__float_as_uint(x), __float_as_uint(x), false, false); return hi ? __uint_as_float(t[0]) : __uint_as_float(t[1]); }
__device__ __forceinline__ float wave_sum(float v) {
    v = red16(v);
    auto s = __builtin_amdgcn_permlane16_swap(__float_as_uint(v), __float_as_uint(v), false, false);
    v = __uint_as_float(s[0]) + __uint_as_float(s[1]);
    return half_sum(v);
}
#define LDS_BARRIER() do { asm volatile("s_waitcnt lgkmcnt(0)" ::: "memory"); __builtin_amdgcn_s_barrier(); asm volatile("" ::: "memory"); } while (0)
#define MFMA32(a, b, c) __builtin_amdgcn_mfma_f32_32x32x16_bf16((a), (b), (c), 0, 0, 0)

struct Args { const float* in[N_IN]; float* out; unsigned char* ws; int ph_lo, ph_hi; };

__device__ __forceinline__ void transpose_item(const float* W, int K, int N, bf16* WT, int ldk, int k0, int n0, int drow0, LAS float* scr, int lane) {
    float tv[32];
#pragma unroll
    for (int i = 0; i < 32; ++i) { const int k = k0 + 2 * i + (lane >> 5); tv[i] = (k < K) ? W[(size_t)k * N + n0 + (lane & 31)] : 0.f; }
#pragma unroll
    for (int i = 0; i < 32; ++i) scr[(2 * i + (lane >> 5)) * 33 + (lane & 31)] = tv[i];
    asm volatile("s_waitcnt lgkmcnt(0)" ::: "memory");
    const int c = lane & 7;
#pragma unroll
    for (int j = 0; j < 4; ++j) { const int n = (lane >> 3) + 8 * j; const LAS float* s = scr + (8 * c) * 33 + n;
        u32x4 o; o.x = pk2(s[0 * 33], s[1 * 33]); o.y = pk2(s[2 * 33], s[3 * 33]); o.z = pk2(s[4 * 33], s[5 * 33]); o.w = pk2(s[6 * 33], s[7 * 33]);
        if (k0 + 8 * c + 8 <= ldk) *(u32x4*)(WT + (size_t)(drow0 + n) * ldk + k0 + 8 * c) = o; }
    asm volatile("s_waitcnt lgkmcnt(0)" ::: "memory");
}
__device__ __forceinline__ void transpose_matrix_item(const float* W, int K, int N, bf16* WT, int ldk, int mode, int item, LAS float* scr, int lane) {
    const int nblk = N / 32, kb = item / nblk, nb = item % nblk, n0 = 32 * nb;
    int drow0 = n0;
    if (mode == 1) { drow0 = (n0 < D_FF) ? (n0 / 128) * 256 + (n0 % 128) : ((n0 - D_FF) / 128) * 256 + 128 + ((n0 - D_FF) % 128); }
    transpose_item(W, K, N, WT, ldk, 64 * kb, n0, drow0, scr, lane);
}
__device__ __forceinline__ void rms_rows2_to_bf16(const float* xrow, const float* g, bf16* orow, int lane) {
    const f32x4* gr = (const f32x4*)g + lane;
    f32x4 v[2][4]; float s[2] = {0.f, 0.f};
#pragma unroll
    for (int q = 0; q < 2; ++q) { const f32x4* xr = (const f32x4*)(xrow + (size_t)q * D_MODEL) + lane;
#pragma unroll
        for (int j = 0; j < 4; ++j) v[q][j] = xr[64 * j]; }
#pragma unroll
    for (int q = 0; q < 2; ++q)
#pragma unroll
        for (int j = 0; j < 4; ++j) s[q] += (v[q][j].x * v[q][j].x + v[q][j].y * v[q][j].y) + (v[q][j].z * v[q][j].z + v[q][j].w * v[q][j].w);
#pragma unroll
    for (int q = 0; q < 2; ++q) {
        const float rs = rsqrtf(wave_sum(s[q]) * (1.f / D_MODEL) + NORM_EPS);
        u32x2* o8 = (u32x2*)(orow + (size_t)q * D_MODEL) + lane;
#pragma unroll
        for (int j = 0; j < 4; ++j) { const f32x4 gg = gr[64 * j]; u32x2 o; o.x = pk2(v[q][j].x * rs * gg.x, v[q][j].y * rs * gg.y); o.y = pk2(v[q][j].z * rs * gg.z, v[q][j].w * rs * gg.w); o8[64 * j] = o; }
    }
}
template <int PART>
__device__ __forceinline__ void prologue(const Args& a, LAS unsigned char* lds, int gw, int NGW, int wave, int lane) {
    LAS float* scr = (LAS float*)(lds + wave * 16384);
    unsigned char* ws = a.ws;
    constexpr int I_FIN = (D_MODEL / 64) * (2 * D_FF / 32), I_FOUT = (D_FF / 64) * (D_MODEL / 32), I_MIN = (D_MODEL / 64) * (MIX_IN / 32), I_SQ = (D_MODEL / 64) * (D_MODEL / 32),
                  I_Q = (D_MODEL / 64) * (MEM_W / 32), I_O = (MEM_W / 64) * (D_MODEL / 32), I_L64 = 16, I_L160 = 48;
    if (PART == 0) {
        constexpr int NITEMS = I_FIN + I_FOUT + I_MIN + I_SQ + 2 * I_L64 + I_L160;
        for (int it = gw; it < NITEMS; it += NGW) {
            int r = it;
            if (r < I_FIN) { transpose_matrix_item(a.in[I_F1WIN], D_MODEL, 2 * D_FF, (bf16*)(ws + WS_W1IN), D_MODEL, 1, r, scr, lane); continue; } r -= I_FIN;
            if (r < I_FOUT) { transpose_matrix_item(a.in[I_F1WOUT], D_FF, D_MODEL, (bf16*)(ws + WS_W1OUT), D_FF, 0, r, scr, lane); continue; } r -= I_FOUT;
            if (r < I_MIN) { transpose_matrix_item(a.in[I_MIXWIN], D_MODEL, MIX_IN, (bf16*)(ws + WS_WMIXIN), D_MODEL, 0, r, scr, lane); continue; } r -= I_MIN;
            if (r < I_SQ) { transpose_matrix_item(a.in[I_WKV], D_MODEL, D_MODEL, (bf16*)(ws + WS_WKV), D_MODEL, 0, r, scr, lane); continue; } r -= I_SQ;
            if (r < I_L64) { transpose_matrix_item(a.in[I_W2], 64, 512, (bf16*)(ws + WS_LW2), 64, 0, r, scr, lane); continue; } r -= I_L64;
            if (r < I_L64) { transpose_matrix_item(a.in[I_A2], 64, 512, (bf16*)(ws + WS_LA2), 64, 0, r, scr, lane); continue; } r -= I_L64;
            transpose_matrix_item(a.in[I_G2], 160, 512, (bf16*)(ws + WS_LG2), 160, 0, r, scr, lane);
        }
        { u32x4* z = (u32x4*)((bf16*)(ws + WS_WMIXIN) + (size_t)MIX_IN * D_MODEL); const int n16 = (LDU - MIX_IN) * D_MODEL * 2 / 16;
          for (int i = gw * 64 + lane; i < n16; i += NGW * 64) z[i] = (u32x4){0u, 0u, 0u, 0u}; }
        for (int m = 2 * gw; m < M_TOK; m += 2 * NGW) rms_rows2_to_bf16(a.in[I_X] + (size_t)m * D_MODEL, a.in[I_F1PRE], (bf16*)(ws + WS_XN) + (size_t)m * D_MODEL, lane);
        for (int m = 2 * gw; m < M_MEM; m += 2 * NGW) rms_rows2_to_bf16(a.in[I_MEM] + (size_t)m * D_MODEL, a.in[I_MEMKVG], (bf16*)(ws + WS_MEMN) + (size_t)m * D_MODEL, lane);
    } else {
        constexpr int NITEMS = I_FIN + I_FOUT + I_SQ + I_Q + I_O;
        for (int it = gw; it < NITEMS; it += NGW) {
            int r = it;
            if (r < I_SQ) { transpose_matrix_item(a.in[I_MIXWOUT], D_MODEL, D_MODEL, (bf16*)(ws + WS_WMIXOUT), D_MODEL, 0, r, scr, lane); continue; } r -= I_SQ;
            if (r < I_Q) { transpose_matrix_item(a.in[I_WQ], D_MODEL, MEM_W, (bf16*)(ws + WS_WQ), D_MODEL, 0, r, scr, lane); continue; } r -= I_Q;
            if (r < I_O) { transpose_matrix_item(a.in[I_WO], MEM_W, D_MODEL, (bf16*)(ws + WS_WO), MEM_W, 0, r, scr, lane); continue; } r -= I_O;
            if (r < I_FIN) { transpose_matrix_item(a.in[I_F2WIN], D_MODEL, 2 * D_FF, (bf16*)(ws + WS_W2IN), D_MODEL, 1, r, scr, lane); continue; } r -= I_FIN;
            transpose_matrix_item(a.in[I_F2WOUT], D_FF, D_MODEL, (bf16*)(ws + WS_W2OUT), D_FF, 0, r, scr, lane);
        }
    }
}
template <bool HIN_BF, bool HOUT_BF>
__device__ __forceinline__ void norm_pass(const bf16* Y, const void* hin_, void* hout_, float coef, const float* gpost, const float* gpre, bf16* XN, int gw, int NGW, int lane) {
    f32x4 gp[4], gq[4];
#pragma unroll
    for (int j = 0; j < 4; ++j) { gp[j] = ((const f32x4*)gpost + lane)[64 * j]; gq[j] = gpre ? ((const f32x4*)gpre + lane)[64 * j] : (f32x4){0.f, 0.f, 0.f, 0.f}; }
    u32x2 ry[2][4]; u32x2 rhb[2][4]; f32x4 rhf[2][4];
#define NP_LOAD(r0) do { _Pragma("unroll") for (int q = 0; q < 2; ++q) { \
        const u32x2* yr = (const u32x2*)(Y + (size_t)((r0) + q) * D_MODEL) + lane; \
        _Pragma("unroll") for (int j = 0; j < 4; ++j) ry[q][j] = yr[64 * j]; \
        if (HIN_BF) { const u32x2* hr = (const u32x2*)((const bf16*)hin_ + (size_t)((r0) + q) * D_MODEL) + lane; _Pragma("unroll") for (int j = 0; j < 4; ++j) rhb[q][j] = hr[64 * j]; } \
        else { const f32x4* hr = (const f32x4*)((const float*)hin_ + (size_t)((r0) + q) * D_MODEL) + lane; _Pragma("unroll") for (int j = 0; j < 4; ++j) rhf[q][j] = hr[64 * j]; } } } while (0)
    int row0 = 2 * gw;
    if (row0 < M_TOK) NP_LOAD(row0);
    for (; row0 < M_TOK; row0 += 2 * NGW) {
        f32x4 y[2][4], h[2][4]; float s[2] = {0.f, 0.f};
#pragma unroll
        for (int q = 0; q < 2; ++q)
#pragma unroll
            for (int j = 0; j < 4; ++j) { const u32x2 t = ry[q][j]; y[q][j] = (f32x4){bflo(t.x), bfhi(t.x), bflo(t.y), bfhi(t.y)};
                if (HIN_BF) { const u32x2 u = rhb[q][j]; h[q][j] = (f32x4){bflo(u.x), bfhi(u.x), bflo(u.y), bfhi(u.y)}; } else h[q][j] = rhf[q][j]; }
        if (row0 + 2 * NGW < M_TOK) NP_LOAD(row0 + 2 * NGW);
#pragma unroll
        for (int q = 0; q < 2; ++q)
#pragma unroll
            for (int j = 0; j < 4; ++j) s[q] += (y[q][j].x * y[q][j].x + y[q][j].y * y[q][j].y) + (y[q][j].z * y[q][j].z + y[q][j].w * y[q][j].w);
#pragma unroll
        for (int q = 0; q < 2; ++q) {
            const float rs = rsqrtf(wave_sum(s[q]) * (1.f / D_MODEL) + NORM_EPS) * coef;
            float s2 = 0.f;
#pragma unroll
            for (int j = 0; j < 4; ++j) { h[q][j] = h[q][j] + y[q][j] * rs * gp[j];
                s2 += (h[q][j].x * h[q][j].x + h[q][j].y * h[q][j].y) + (h[q][j].z * h[q][j].z + h[q][j].w * h[q][j].w); }
            if (HOUT_BF) { u32x2* orow = (u32x2*)((bf16*)hout_ + (size_t)(row0 + q) * D_MODEL) + lane;
#pragma unroll
                for (int j = 0; j < 4; ++j) { u32x2 o; o.x = pk2(h[q][j].x, h[q][j].y); o.y = pk2(h[q][j].z, h[q][j].w); orow[64 * j] = o; } }
            else { f32x4* orow = (f32x4*)((float*)hout_ + (size_t)(row0 + q) * D_MODEL) + lane;
#pragma unroll
                for (int j = 0; j < 4; ++j) orow[64 * j] = h[q][j]; }
            if (gpre) {
                const float rs2 = rsqrtf(wave_sum(s2) * (1.f / D_MODEL) + NORM_EPS);
                u32x2* o8 = (u32x2*)(XN + (size_t)(row0 + q) * D_MODEL) + lane;
#pragma unroll
                for (int j = 0; j < 4; ++j) { const f32x4 g = gq[j]; u32x2 o; o.x = pk2(h[q][j].x * rs2 * g.x, h[q][j].y * rs2 * g.y); o.y = pk2(h[q][j].z * rs2 * g.z, h[q][j].w * rs2 * g.w); o8[64 * j] = o; }
            }
        }
    }
#undef NP_LOAD
}
constexpr int SB_KP = 72, SB_VP = 72;
typedef short v4i16_t __attribute__((ext_vector_type(4)));
__device__ __forceinline__ s16x4 lds_tr16(const LAS bf16* p) { return __builtin_bit_cast(s16x4, __builtin_amdgcn_ds_read_tr16_b64_v4i16((LAS v4i16_t*)p)); }
__device__ __forceinline__ void sb_unit(LAS unsigned char* lds, const bf16* U, bf16* MIX, const float* sbg, int b, int h, int qb, const int tid) {
    const int wave = tid >> 6, lane = tid & 63, j = lane & 31, hi = lane >> 5;
    LAS bf16* Ks = (LAS bf16*)lds;
    LAS bf16* Vt = (LAS bf16*)(lds + 64 * SB_KP * 2);
    const int qw = 256 * qb + 32 * wave;
    const size_t rowbase = (size_t)b * SEQ;
    bf16x8 qf[4];
    { const bf16* qp = U + (rowbase + qw + j) * LDU + h * 64 + 8 * hi;
#pragma unroll
      for (int ks = 0; ks < 4; ++ks) { const u32x4 raw = *(const u32x4*)(qp + 16 * ks); u32x4 sc;
          const float qs = 0.125f * 1.4426950408889634f;
          sc.x = pk2(bflo(raw.x) * qs, bfhi(raw.x) * qs); sc.y = pk2(bflo(raw.y) * qs, bfhi(raw.y) * qs);
          sc.z = pk2(bflo(raw.z) * qs, bfhi(raw.z) * qs); sc.w = pk2(bflo(raw.w) * qs, bfhi(raw.w) * qs);
          qf[ks] = __builtin_bit_cast(bf16x8, sc); } }
    f32x16 o0, o1;
#pragma unroll
    for (int r = 0; r < 16; ++r) { o0[r] = 0.f; o1[r] = 0.f; }
    float carry = 1.f;
    const int st_key = tid >> 3, st_dg = tid & 7;
    const bf16* kp0 = U + (rowbase + st_key) * LDU + 512 + h * 64 + 8 * st_dg;
    u32x4 kv = *(const u32x4*)(kp0 + (size_t)(64 * (4 * qb + 3)) * LDU), vv = *(const u32x4*)(kp0 + (size_t)(64 * (4 * qb + 3)) * LDU + 512);
    for (int jt = 4 * qb + 3; jt >= 0; --jt) {
        LDS_BARRIER();
        { *(LAS u32x4*)(Ks + st_key * SB_KP + 8 * st_dg) = kv;
          *(LAS u32x4*)(Vt + st_key * SB_VP + 8 * st_dg) = vv; }
        LDS_BARRIER();
        if (jt > 0) { kv = *(const u32x4*)(kp0 + (size_t)(64 * (jt - 1)) * LDU); vv = *(const u32x4*)(kp0 + (size_t)(64 * (jt - 1)) * LDU + 512); }
#pragma unroll 1
        for (int sub = 1; sub >= 0; --sub) {
            const int kbase = 64 * jt + 32 * sub;
            if (kbase > qw) continue;
            f32x16 acc;
#pragma unroll
            for (int r = 0; r < 16; ++r) acc[r] = 0.f;
#pragma unroll
            for (int ks = 0; ks < 4; ++ks) { const bf16x8 a = *(const LAS bf16x8*)(Ks + (32 * sub + j) * SB_KP + 16 * ks + 8 * hi); acc = MFMA32(a, qf[ks], acc); }
            const bool diag = (kbase == qw);
            float e[16], incl[16];
#pragma unroll
            for (int r = 0; r < 16; ++r) { const int i = 8 * (r >> 2) + 4 * hi + (r & 3); const float z = fminf(acc[r], 115.f);
                float ev = __builtin_amdgcn_exp2f(z); float dv = __builtin_amdgcn_rcpf(1.f + ev);
                if (diag && i >= j) { ev = 0.f; dv = 1.f; }
                e[r] = ev; incl[r] = dv; }
            float GP[4], GPo[4];
#pragma unroll
            for (int g = 0; g < 4; ++g) { incl[4 * g + 2] *= incl[4 * g + 3]; incl[4 * g + 1] *= incl[4 * g + 2]; incl[4 * g] *= incl[4 * g + 1]; GP[g] = incl[4 * g]; GPo[g] = half_other(GP[g], hi); }
            float ma[4], oi[4], base[4];
            ma[3] = 1.f; ma[2] = GP[3]; ma[1] = GP[2] * ma[2]; ma[0] = GP[1] * ma[1];
            oi[3] = GPo[3]; oi[2] = GPo[2] * oi[3]; oi[1] = GPo[1] * oi[2]; oi[0] = GPo[0] * oi[1];
            base[0] = carry * ma[0] * (hi ? oi[1] : oi[0]); base[1] = carry * ma[1] * (hi ? oi[2] : oi[1]);
            base[2] = carry * ma[2] * (hi ? oi[3] : oi[2]); base[3] = carry * ma[3] * (hi ? 1.f : oi[3]);
            carry = carry * ((GP[0] * ma[0]) * oi[0]);
            u32x4 p0, p1;
            p0.x = pk2(e[0] * incl[0] * base[0], e[1] * incl[1] * base[0]); p0.y = pk2(e[2] * incl[2] * base[0], e[3] * incl[3] * base[0]);
            p0.z = pk2(e[4] * incl[4] * base[1], e[5] * incl[5] * base[1]); p0.w = pk2(e[6] * incl[6] * base[1], e[7] * incl[7] * base[1]);
            p1.x = pk2(e[8] * incl[8] * base[2], e[9] * incl[9] * base[2]); p1.y = pk2(e[10] * incl[10] * base[2], e[11] * incl[11] * base[2]);
            p1.z = pk2(e[12] * incl[12] * base[3], e[13] * incl[13] * base[3]); p1.w = pk2(e[14] * incl[14] * base[3], e[15] * incl[15] * base[3]);
            const bf16x8 pa0 = __builtin_bit_cast(bf16x8, p0), pa1 = __builtin_bit_cast(bf16x8, p1);
#pragma unroll
            for (int s = 0; s < 2; ++s) {
                const bf16x8 pb = s ? pa1 : pa0;
                const LAS bf16* vp = Vt + (32 * sub + 16 * s + 4 * hi + ((lane & 15) >> 2)) * SB_VP + 16 * ((lane >> 4) & 1) + 4 * (lane & 3);
                { const s16x4 lo = lds_tr16(vp), hh = lds_tr16(vp + 8 * SB_VP); const bf16x8 va = __builtin_shufflevector(lo, hh, 0, 1, 2, 3, 4, 5, 6, 7); o0 = MFMA32(va, pb, o0); }
                { const s16x4 lo = lds_tr16(vp + 32), hh = lds_tr16(vp + 8 * SB_VP + 32); const bf16x8 va = __builtin_shufflevector(lo, hh, 0, 1, 2, 3, 4, 5, 6, 7); o1 = MFMA32(va, pb, o1); }
            }
        }
    }
    float ss = 0.f;
#pragma unroll
    for (int r = 0; r < 16; ++r) ss += o0[r] * o0[r] + o1[r] * o1[r];
    ss = half_sum(ss);
    const float rs = rsqrtf(ss * (1.f / 64.f) + NORM_EPS);
    bf16* op = MIX + (rowbase + qw + j) * D_MODEL + h * 64 + 4 * hi;
    const float* gp = sbg + h * 64 + 4 * hi;
#pragma unroll
    for (int g = 0; g < 4; ++g) {
        const f32x4 g0 = *(const f32x4*)(gp + 8 * g), g1 = *(const f32x4*)(gp + 32 + 8 * g);
        u32x2 w0, w1;
        w0.x = pk2(o0[4 * g] * rs * g0.x, o0[4 * g + 1] * rs * g0.y); w0.y = pk2(o0[4 * g + 2] * rs * g0.z, o0[4 * g + 3] * rs * g0.w);
        w1.x = pk2(o1[4 * g] * rs * g1.x, o1[4 * g + 1] * rs * g1.y); w1.y = pk2(o1[4 * g + 2] * rs * g1.z, o1[4 * g + 3] * rs * g1.w);
        *(u32x2*)(op + 8 * g) = w0; *(u32x2*)(op + 32 + 8 * g) = w1;
    }
}

constexpr int XA_KP = 136, XA_VP = 136;
__device__ __forceinline__ void xatt_stage(LAS unsigned char* lds, const bf16* KVm, int b, int mh, const int tid) {
    LAS bf16* Ks = (LAS bf16*)lds;
    LAS bf16* Vt = (LAS bf16*)(lds + 256 * XA_KP * 2);
    const bf16* base = KVm + (size_t)b * MEM_LEN * D_MODEL + mh * 128;
    u32x4 kv[8];
#pragma unroll
    for (int i = 0; i < 8; ++i) { const int p = tid + 512 * i, key = p >> 4, dg = p & 15; kv[i] = *(const u32x4*)(base + (size_t)key * D_MODEL + 8 * dg); }
#pragma unroll
    for (int i = 0; i < 8; ++i) { const int p = tid + 512 * i, key = p >> 4, dg = p & 15; *(LAS u32x4*)(Ks + key * XA_KP + 8 * dg) = kv[i]; }
#pragma unroll
    for (int i = 0; i < 8; ++i) { const int p = tid + 512 * i, key = p >> 4, dg = p & 15; kv[i] = *(const u32x4*)(base + (size_t)key * D_MODEL + 512 + 8 * dg); }
#pragma unroll
    for (int i = 0; i < 8; ++i) { const int p = tid + 512 * i, key = p >> 4, dg = p & 15; *(LAS u32x4*)(Vt + key * XA_VP + 8 * dg) = kv[i]; }
}
__device__ __forceinline__ void xatt_unit(LAS unsigned char* lds, const bf16* Qm, bf16* Om, int b, int mh, int qb, const int tid) {
    const int wave = tid >> 6, lane = tid & 63, j = lane & 31, hi = lane >> 5;
    LAS bf16* Ks = (LAS bf16*)lds;
    LAS bf16* Vt = (LAS bf16*)(lds + 256 * XA_KP * 2);
    const int qw = 256 * qb + 32 * wave;
    const size_t qrow = (size_t)b * SEQ + qw + j;
    bf16x8 qf[8];
    { const bf16* qp = Qm + qrow * MEM_W + mh * 128 + 8 * hi;
#pragma unroll
      for (int ks = 0; ks < 8; ++ks) qf[ks] = *(const bf16x8*)(qp + 16 * ks); }
    f32x16 o[4];
#pragma unroll
    for (int t = 0; t < 4; ++t)
#pragma unroll
        for (int r = 0; r < 16; ++r) o[t][r] = 0.f;
    float mrun = -1e30f, lsum = 0.f;
    const float scale = 0.08838834764831845f;
#pragma unroll 1
    for (int sub = 0; sub < 8; ++sub) {
        f32x16 acc;
#pragma unroll
        for (int r = 0; r < 16; ++r) acc[r] = 0.f;
#pragma unroll
        for (int ks = 0; ks < 8; ++ks) { const bf16x8 a = *(const LAS bf16x8*)(Ks + (32 * sub + j) * XA_KP + 16 * ks + 8 * hi); acc = MFMA32(a, qf[ks], acc); }
        float mx = -1e30f;
#pragma unroll
        for (int r = 0; r < 16; ++r) { acc[r] *= scale; mx = fmaxf(mx, acc[r]); }
        mx = half_max(mx);
        const float mnew = fmaxf(mrun, mx), corr = __expf(mrun - mnew);
        mrun = mnew; lsum *= corr;
        float p[16];
#pragma unroll
        for (int r = 0; r < 16; ++r) { p[r] = __expf(acc[r] - mnew); lsum += p[r]; }
#pragma unroll
        for (int t = 0; t < 4; ++t)
#pragma unroll
            for (int r = 0; r < 16; ++r) o[t][r] *= corr;
        u32x4 p0, p1;
        p0.x = pk2(p[0], p[1]); p0.y = pk2(p[2], p[3]); p0.z = pk2(p[4], p[5]); p0.w = pk2(p[6], p[7]);
        p1.x = pk2(p[8], p[9]); p1.y = pk2(p[10], p[11]); p1.z = pk2(p[12], p[13]); p1.w = pk2(p[14], p[15]);
        const bf16x8 pa0 = __builtin_bit_cast(bf16x8, p0), pa1 = __builtin_bit_cast(bf16x8, p1);
#pragma unroll
        for (int s = 0; s < 2; ++s) {
            const bf16x8 pb = s ? pa1 : pa0;
#pragma unroll
            for (int t = 0; t < 4; ++t) {
                const LAS bf16* vp = Vt + (32 * sub + 16 * s + 4 * hi + ((lane & 15) >> 2)) * XA_VP + 32 * t + 16 * ((lane >> 4) & 1) + 4 * (lane & 3);
                const s16x4 lo = lds_tr16(vp), hh = lds_tr16(vp + 8 * XA_VP); const bf16x8 va = __builtin_shufflevector(lo, hh, 0, 1, 2, 3, 4, 5, 6, 7);
                o[t] = MFMA32(va, pb, o[t]);
            }
        }
    }
    lsum = half_sum(lsum);
    const float inv = 1.f / lsum;
    bf16* op = Om + qrow * MEM_W + mh * 128 + 4 * hi;
#pragma unroll
    for (int t = 0; t < 4; ++t)
#pragma unroll
        for (int g = 0; g < 4; ++g) { u32x2 w; w.x = pk2(o[t][4 * g] * inv, o[t][4 * g + 1] * inv); w.y = pk2(o[t][4 * g + 2] * inv, o[t][4 * g + 3] * inv); *(u32x2*)(op + 32 * t + 8 * g) = w; }
}

constexpr int RW_P = 68;
constexpr int RW_ARR = 32 * RW_P * 4;
constexpr int RW_XWP = 72, RW_XGP = 168;
__device__ __forceinline__ void rw_lerp8(const u32x4 cu, const u32x4 pr, const LAS float* mu, float (&v)[8]) {
    const f32x4 m0 = *(const LAS f32x4*)mu, m1 = *(const LAS f32x4*)(mu + 4);
    float x, p;
    x = bflo(cu.x); p = bflo(pr.x); v[0] = x + (p - x) * m0.x;  x = bfhi(cu.x); p = bfhi(pr.x); v[1] = x + (p - x) * m0.y;
    x = bflo(cu.y); p = bflo(pr.y); v[2] = x + (p - x) * m0.z;  x = bfhi(cu.y); p = bfhi(pr.y); v[3] = x + (p - x) * m0.w;
    x = bflo(cu.z); p = bflo(pr.z); v[4] = x + (p - x) * m1.x;  x = bfhi(cu.z); p = bfhi(pr.z); v[5] = x + (p - x) * m1.y;
    x = bflo(cu.w); p = bflo(pr.w); v[6] = x + (p - x) * m1.z;  x = bfhi(cu.w); p = bfhi(pr.w); v[7] = x + (p - x) * m1.w;
}
__device__ __forceinline__ void rw_st_f32(LAS float* dst, const float (&v)[8]) { *(LAS f32x4*)dst = (f32x4){v[0], v[1], v[2], v[3]}; *(LAS f32x4*)(dst + 4) = (f32x4){v[4], v[5], v[6], v[7]}; }
__device__ __forceinline__ void rw_st_bf16(LAS bf16* dst, const float (&v)[8]) { u32x4 w; w.x = pk2(v[0], v[1]); w.y = pk2(v[2], v[3]); w.z = pk2(v[4], v[5]); w.w = pk2(v[6], v[7]); *(LAS u32x4*)dst = w; }
__device__ __forceinline__ void rwkv_head(LAS unsigned char* lds, const Args& a, const bf16* U, bf16* MIX, int b, int h, const int tid) {
    const int wave = __builtin_amdgcn_readfirstlane(tid >> 6), lane = tid & 63;
    LAS float* R = (LAS float*)(lds + 0 * RW_ARR); LAS float* Wd = (LAS float*)(lds + 1 * RW_ARR); LAS float* Kk = (LAS float*)(lds + 2 * RW_ARR); LAS float* Vv = (LAS float*)(lds + 3 * RW_ARR);
    LAS float* Aa = (LAS float*)(lds + 4 * RW_ARR); LAS float* Bb = (LAS float*)(lds + 5 * RW_ARR); LAS float* Gg = (LAS float*)(lds + 6 * RW_ARR); LAS float* Yy = (LAS float*)(lds + 7 * RW_ARR);
    LAS float* RK = (LAS float*)(lds + 8 * RW_ARR);
    LAS float* MU = (LAS float*)(lds + 8 * RW_ARR + 256);
    LAS bf16* XW = (LAS bf16*)(lds + 8 * RW_ARR + 256 + 2048); LAS bf16* XA = XW + 32 * RW_XWP; LAS bf16* XG = XA + 32 * RW_XWP;
    const int tok = tid >> 4, l16 = tid & 15, lo8 = (l16 < 8), l7 = l16 & 7;
    const int col0 = lo8 ? 64 * h + 8 * l7 : 512 + 64 * h + 8 * l7;
    const int col1 = lo8 ? 1024 + 64 * h + 8 * l7 : 1600 + 8 * l7;
    const int col2 = lo8 ? 1536 + 8 * l7 : 1664 + 8 * l7;
    const int col3 = 1728 + 8 * l16;
    __syncthreads();
    if (tid < 64) { const int i = tid >> 4, q = tid & 15; const bool q8 = q < 8; const int q7 = q & 7;
        const int cc = (i == 0) ? (q8 ? 64 * h + 8 * q7 : 512 + 64 * h + 8 * q7) : (i == 1) ? (q8 ? 1024 + 64 * h + 8 * q7 : 1600 + 8 * q7) : (i == 2) ? (q8 ? 1536 + 8 * q7 : 1664 + 8 * q7) : (q < 12 ? 1728 + 8 * q : 1728);
        const float* mu = a.in[I_MU] + cc;
#pragma unroll
        for (int e = 0; e < 8; ++e) MU[(i * 16 + q) * 8 + e] = mu[e]; }
    const int c4 = 4 * l16, gc = 64 * h + c4;
    const f32x4 kkw = *(const f32x4*)(a.in[I_KK] + gc), kaw = *(const f32x4*)(a.in[I_KA] + gc), rkw = *(const f32x4*)(a.in[I_RK] + gc);
    const f32x4 lg = *(const f32x4*)(a.in[I_LNG] + gc), lb = *(const f32x4*)(a.in[I_LNB] + gc);
    const int lkind = wave >> 1, lnt = wave & 1, lj = lane & 31, lhi = lane >> 5;
    const int lnks = (lkind == 2) ? 10 : 4;
    const int lgcol = 64 * h + 32 * lnt + lj;
    bf16x8 wf[10];
    float lbias = 0.f;
    if (wave < 6) {
        const bf16* wb = (lkind == 0 ? (const bf16*)(a.ws + WS_LW2) + (size_t)lgcol * 64 : lkind == 1 ? (const bf16*)(a.ws + WS_LA2) + (size_t)lgcol * 64 : (const bf16*)(a.ws + WS_LG2) + (size_t)lgcol * 160) + 8 * lhi;
#pragma unroll
        for (int ks = 0; ks < 10; ++ks) if (ks < lnks) wf[ks] = *(const bf16x8*)(wb + 16 * ks);
        if (lkind == 0) lbias = a.in[I_W0][lgcol]; else if (lkind == 1) lbias = a.in[I_A0][lgcol];
    }
    const int srow = 8 * wave + 2 * (lane >> 4), kl = lane & 15;
    f32x4 pvv = {0.f, 0.f, 0.f, 0.f}, pgg = {0.f, 0.f, 0.f, 0.f}; float prk = 0.f;
    float S00 = 0.f, S01 = 0.f, S02 = 0.f, S03 = 0.f, S10 = 0.f, S11 = 0.f, S12 = 0.f, S13 = 0.f;
    const bf16* ubase = U + ((size_t)b * SEQ + tok) * LDU + RW_OFF;
    u32x4 cu0, cu1, cu2, cu3, pr0, pr1, pr2, pr3;
    const u32x4 z4 = (u32x4){0u, 0u, 0u, 0u};
    cu0 = *(const u32x4*)(ubase + col0); cu1 = *(const u32x4*)(ubase + col1); cu2 = *(const u32x4*)(ubase + col2); cu3 = (l16 < 12) ? *(const u32x4*)(ubase + col3) : z4;
    pr0 = z4; pr1 = z4; pr2 = z4; pr3 = z4;
    if (tok > 0) { pr0 = *(const u32x4*)(ubase - LDU + col0); pr1 = *(const u32x4*)(ubase - LDU + col1); pr2 = *(const u32x4*)(ubase - LDU + col2); if (l16 < 12) pr3 = *(const u32x4*)(ubase - LDU + col3); }
    __syncthreads();
    for (int c = 0; c < SEQ / 32; ++c) {
        const int t0 = 32 * c;
        {
            float v[8];
            rw_lerp8(cu0, pr0, MU + (0 * 16 + l16) * 8, v); rw_st_f32((lo8 ? R : Kk) + tok * RW_P + 8 * l7, v);
            rw_lerp8(cu1, pr1, MU + (1 * 16 + l16) * 8, v);
            if (lo8) rw_st_f32(Vv + tok * RW_P + 8 * l7, v); else rw_st_bf16(XA + tok * RW_XWP + 8 * l7, v);
            rw_lerp8(cu2, pr2, MU + (2 * 16 + l16) * 8, v);
            { const float s0 = lo8 ? -2.f : -1.f, s1 = lo8 ? 2.f : 1.f, s2 = lo8 ? -1.f : 0.f;
#pragma unroll
              for (int i = 0; i < 8; ++i) { const float xx = fminf(fmaxf(v[i], -30.f), 30.f); v[i] = fmaf(s1, __builtin_amdgcn_rcpf(1.f + __expf(s0 * xx)), s2); }
              rw_st_bf16((lo8 ? XW + tok * RW_XWP : XG + tok * RW_XGP) + 8 * l7, v); }
            if (l16 < 12) {
                rw_lerp8(cu3, pr3, MU + (3 * 16 + l16) * 8, v);
#pragma unroll
                for (int i = 0; i < 8; ++i) v[i] = __builtin_amdgcn_rcpf(1.f + __expf(-v[i]));
                rw_st_bf16(XG + tok * RW_XGP + 64 + 8 * l16, v); }
        }
        LDS_BARRIER();
        if (c + 1 < SEQ / 32) {
            const bf16* ub = ubase + (size_t)(t0 + 32) * LDU;
            cu0 = *(const u32x4*)(ub + col0); cu1 = *(const u32x4*)(ub + col1); cu2 = *(const u32x4*)(ub + col2); if (l16 < 12) cu3 = *(const u32x4*)(ub + col3);
            pr0 = *(const u32x4*)(ub - LDU + col0); pr1 = *(const u32x4*)(ub - LDU + col1); pr2 = *(const u32x4*)(ub - LDU + col2); if (l16 < 12) pr3 = *(const u32x4*)(ub - LDU + col3);
        }
        if (wave < 6) {
            const LAS bf16* xa = (lkind == 0 ? XW + lj * RW_XWP : lkind == 1 ? XA + lj * RW_XWP : XG + lj * RW_XGP) + 8 * lhi;
            f32x16 acc;
#pragma unroll
            for (int r = 0; r < 16; ++r) acc[r] = 0.f;
#pragma unroll
            for (int ks = 0; ks < 10; ++ks) if (ks < lnks) { const bf16x8 av = *(const LAS bf16x8*)(xa + 16 * ks); acc = MFMA32(av, wf[ks], acc); }
            const int col = 32 * lnt + lj;
            if (lkind == 0) {
#pragma unroll
                for (int r = 0; r < 16; ++r) { const int tk = 8 * (r >> 2) + 4 * lhi + (r & 3); const float x = lbias + acc[r];
                    const float w = -__logf(1.f + __expf(-x)) - 0.5f; Wd[tk * RW_P + col] = __expf(-__expf(w)); }
            } else if (lkind == 1) {
#pragma unroll
                for (int r = 0; r < 16; ++r) { const int tk = 8 * (r >> 2) + 4 * lhi + (r & 3); Bb[tk * RW_P + col] = __builtin_amdgcn_rcpf(1.f + __expf(-(lbias + acc[r]))); }
            } else {
#pragma unroll
                for (int r = 0; r < 16; ++r) { const int tk = 8 * (r >> 2) + 4 * lhi + (r & 3); Gg[tk * RW_P + col] = acc[r]; }
            }
        }
        LDS_BARRIER();
        {
            if (c > 0) {
                f32x4 y; { const LAS float* yq = (const LAS float*)(lds + 94208) + (((tok >> 1) * 32 + 2 * l16) * 4) * 4 + (tok & 1) * 2;
                  const f32x2 a0 = *(const LAS f32x2*)yq, a1 = *(const LAS f32x2*)(yq + 4), a2 = *(const LAS f32x2*)(yq + 8), a3 = *(const LAS f32x2*)(yq + 12), b0 = *(const LAS f32x2*)(yq + 16), b1 = *(const LAS f32x2*)(yq + 20), b2 = *(const LAS f32x2*)(yq + 24), b3 = *(const LAS f32x2*)(yq + 28);
                  y = (f32x4){(a0.x + a1.x) + (a2.x + a3.x), (a0.y + a1.y) + (a2.y + a3.y), (b0.x + b1.x) + (b2.x + b3.x), (b0.y + b1.y) + (b2.y + b3.y)}; }
                const float mean = red16((y.x + y.y) + (y.z + y.w)) * (1.f / 64.f);
                const f32x4 d = y - mean;
                const float var = red16((d.x * d.x + d.y * d.y) + (d.z * d.z + d.w * d.w)) * (1.f / 64.f);
                const float rs = rsqrtf(var + LNX_EPS);
                const f32x4 o = (d * rs * lg + lb + prk * pvv) * pgg;
                u32x2 w; w.x = pk2(o.x, o.y); w.y = pk2(o.z, o.w);
                *(u32x2*)(MIX + ((size_t)b * SEQ + t0 - 32 + tok) * D_MODEL + 512 + gc) = w;
            }
            const f32x4 kr = *(LAS f32x4*)(Kk + tok * RW_P + c4), al = *(LAS f32x4*)(Bb + tok * RW_P + c4), rr = *(LAS f32x4*)(R + tok * RW_P + c4);
            pvv = *(LAS f32x4*)(Vv + tok * RW_P + c4); pgg = *(LAS f32x4*)(Gg + tok * RW_P + c4);
            f32x4 kkv = kr * kkw;
            const float ssq = red16((kkv.x * kkv.x + kkv.y * kkv.y) + (kkv.z * kkv.z + kkv.w * kkv.w));
            const float inv = 1.f / fmaxf(sqrtf(ssq), 1e-12f);
            kkv = kkv * inv;
            const f32x4 km = kr * (1.f + (al - 1.f) * kaw);
            *(LAS f32x4*)(Aa + tok * RW_P + c4) = -kkv;
            *(LAS f32x4*)(Bb + tok * RW_P + c4) = kkv * al;
            *(LAS f32x4*)(Kk + tok * RW_P + c4) = km;
            const f32x4 pr = rr * km * rkw;
            prk = red16((pr.x + pr.y) + (pr.z + pr.w));
        }
        LDS_BARRIER();
        {
            const unsigned ak = (unsigned)(size_t)lds + 16u * kl, av = (unsigned)(size_t)lds + 3u * RW_ARR + 4u * srow;
            const unsigned yaddr = (unsigned)(size_t)(lds + 94208 + ((srow >> 1) * 4 + (kl >> 2)) * 16);
            float py0 = 0.f, py1 = 0.f;
#define RW_LDS_STEP(tt) do { const unsigned _a = ak + (unsigned)((tt) * RW_P * 4), _v = av + (unsigned)((tt) * RW_P * 4); \
                asm volatile("ds_read_b128 %0, %1 offset:34816" : "=v"(na) : "v"(_a)); asm volatile("ds_read_b128 %0, %1 offset:8704" : "=v"(nw) : "v"(_a)); \
                asm volatile("ds_read_b128 %0, %1 offset:43520" : "=v"(nb) : "v"(_a)); asm volatile("ds_read_b128 %0, %1 offset:17408" : "=v"(nk) : "v"(_a)); \
                asm volatile("ds_read_b128 %0, %1" : "=v"(nr) : "v"(_a)); asm volatile("ds_read_b64 %0, %1" : "=v"(nv) : "v"(_v)); } while (0)
            f32x4 na, nw, nb, nk, nr; f32x2 nv;
            RW_LDS_STEP(0);
            asm volatile("s_waitcnt lgkmcnt(0)" : "+v"(na), "+v"(nw), "+v"(nb), "+v"(nk), "+v"(nr), "+v"(nv));
#pragma unroll 4
            for (int t = 0; t < 32; ++t) {
                const f32x4 a4 = na, w4 = nw, b4 = nb, k4 = nk, r4 = nr; const f32x2 v2 = nv;
                RW_LDS_STEP((t + 1) & 31);
                float sa0 = fmaf(S03, a4.w, fmaf(S02, a4.z, fmaf(S01, a4.y, S00 * a4.x)));
                float sa1 = fmaf(S13, a4.w, fmaf(S12, a4.z, fmaf(S11, a4.y, S10 * a4.x)));
                sa0 = red16(sa0); sa1 = red16(sa1);
                S00 = fmaf(v2.x, k4.x, fmaf(sa0, b4.x, S00 * w4.x)); S01 = fmaf(v2.x, k4.y, fmaf(sa0, b4.y, S01 * w4.y));
                S02 = fmaf(v2.x, k4.z, fmaf(sa0, b4.z, S02 * w4.z)); S03 = fmaf(v2.x, k4.w, fmaf(sa0, b4.w, S03 * w4.w));
                S10 = fmaf(v2.y, k4.x, fmaf(sa1, b4.x, S10 * w4.x)); S11 = fmaf(v2.y, k4.y, fmaf(sa1, b4.y, S11 * w4.y));
                S12 = fmaf(v2.y, k4.z, fmaf(sa1, b4.z, S12 * w4.z)); S13 = fmaf(v2.y, k4.w, fmaf(sa1, b4.w, S13 * w4.w));
                float y0 = fmaf(S03, r4.w, fmaf(S02, r4.z, fmaf(S01, r4.y, S00 * r4.x)));
                float y1 = fmaf(S13, r4.w, fmaf(S12, r4.z, fmaf(S11, r4.y, S10 * r4.x)));
                asm volatile("" : "+v"(y0), "+v"(y1));
                y0 += dppf<0xB1>(y0); y1 += dppf<0xB1>(y1); y0 += dppf<0x4E>(y0); y1 += dppf<0x4E>(y1);
                asm volatile("" : "+v"(y0), "+v"(y1));
                if ((t & 1) == 0) { py0 = y0; py1 = y1; }
                else { const f32x4 yv = {py0, py1, y0, y1}; asm volatile("ds_write_b128 %0, %1" :: "v"(yaddr + (unsigned)((t >> 1) * 2048)), "v"(yv)); }
                asm volatile("s_waitcnt lgkmcnt(0)" : "+v"(na), "+v"(nw), "+v"(nb), "+v"(nk), "+v"(nr), "+v"(nv));
            }
        }
        LDS_BARRIER();
    }
    {
        f32x4 y; { const LAS float* yq = (const LAS float*)(lds + 94208) + (((tok >> 1) * 32 + 2 * l16) * 4) * 4 + (tok & 1) * 2;
                  const f32x2 a0 = *(const LAS f32x2*)yq, a1 = *(const LAS f32x2*)(yq + 4), a2 = *(const LAS f32x2*)(yq + 8), a3 = *(const LAS f32x2*)(yq + 12), b0 = *(const LAS f32x2*)(yq + 16), b1 = *(const LAS f32x2*)(yq + 20), b2 = *(const LAS f32x2*)(yq + 24), b3 = *(const LAS f32x2*)(yq + 28);
                  y = (f32x4){(a0.x + a1.x) + (a2.x + a3.x), (a0.y + a1.y) + (a2.y + a3.y), (b0.x + b1.x) + (b2.x + b3.x), (b0.y + b1.y) + (b2.y + b3.y)}; }
        const float mean = red16((y.x + y.y) + (y.z + y.w)) * (1.f / 64.f);
        const f32x4 d = y - mean;
        const float var = red16((d.x * d.x + d.y * d.y) + (d.z * d.z + d.w * d.w)) * (1.f / 64.f);
        const float rs = rsqrtf(var + LNX_EPS);
        const f32x4 o = (d * rs * lg + lb + prk * pvv) * pgg;
        u32x2 w; w.x = pk2(o.x, o.y); w.y = pk2(o.z, o.w);
        *(u32x2*)(MIX + ((size_t)b * SEQ + SEQ - 32 + tok) * D_MODEL + 512 + gc) = w;
    }
    __syncthreads();
}

#define XB_TMO      128
#define XB_XCNT(j)  (256  + 64 * (j))
#define XB_XSUB(j)  (1280 + 64 * (j))
#define XB_XGEN(j)  (2304 + 64 * (j))
#define XB_TOP      3328
#define XB_TOPGEN   3392
#define XCD_BAR_WORDS 3456
#define XB_SPIN_CAP (1u << 18)

__device__ __forceinline__ unsigned xb_ld(unsigned* p)              { return __hip_atomic_load(p, __ATOMIC_RELAXED, __HIP_MEMORY_SCOPE_AGENT); }
__device__ __forceinline__ unsigned xb_add(unsigned* p, unsigned v) { return __hip_atomic_fetch_add(p, v, __ATOMIC_RELAXED, __HIP_MEMORY_SCOPE_AGENT); }
__device__ __forceinline__ unsigned xb_xcc_id() { return (unsigned)__builtin_amdgcn_s_getreg((3 << 11) | 20) & 0xFu; }
#define XB_SPIN(cond, bar) do { unsigned _sp = 0; while (cond) { __builtin_amdgcn_s_sleep(1); \
    if ((++_sp & 255u) == 0u) { if (xb_ld(&(bar)[XB_TMO])) break; if (_sp > XB_SPIN_CAP) { atomicAdd(&(bar)[XB_TMO], 1u); break; } } } } while (0)

struct XcdBarrier {
    unsigned* bar; unsigned x;
    volatile LAS unsigned* st;
};

__device__ __forceinline__ XcdBarrier xcd_barrier_post(unsigned* bar, volatile LAS unsigned* st) {
    XcdBarrier b; b.bar = bar; b.x = xb_xcc_id(); b.st = st;
    if (threadIdx.x == 0) (void)xb_add(&bar[XB_XCNT(b.x)], 1u);
    return b;
}
__device__ __forceinline__ void xcd_barrier_complete(unsigned* bar, unsigned x, unsigned& nloc, unsigned& nx) {
    const unsigned G = gridDim.x * gridDim.y * gridDim.z;
    unsigned sum, cnt, mine, sp = 0u;
    for (;;) {
        sum = 0u; cnt = 0u; mine = 0u;
#pragma unroll
        for (unsigned j = 0; j < 16; ++j) { const unsigned c = xb_ld(&bar[XB_XCNT(j)]); sum += c; cnt += (c > 0u) ? 1u : 0u; mine = (j == x) ? c : mine; }
        if (sum == G) break;
        __builtin_amdgcn_s_sleep(1);
        if ((++sp & 255u) == 0u) { if (xb_ld(&bar[XB_TMO])) break; if (sp > XB_SPIN_CAP) { atomicAdd(&bar[XB_TMO], 1u); break; } }
    }
    nloc = mine > 0u ? mine : 1u; nx = cnt > 0u ? cnt : 1u;
}

__device__ __forceinline__ void xcd_barrier(const XcdBarrier& b) {
    asm volatile("s_waitcnt vmcnt(0)" ::: "memory");
    __syncthreads();
    if (threadIdx.x == 0) {
        unsigned* bar = b.bar;
        __builtin_amdgcn_s_waitcnt(0);
        unsigned nloc = b.st[0], nx = b.st[1];
        if (nloc == 0u) { xcd_barrier_complete(bar, b.x, nloc, nx); b.st[0] = nloc; b.st[1] = nx; }
        const unsigned old = xb_add(&bar[XB_XSUB(b.x)], 1u);
        const unsigned gen = old / nloc;
        if (old + 1u == (gen + 1u) * nloc) {
            __builtin_amdgcn_fence(__ATOMIC_RELEASE, "agent");
            asm volatile("s_waitcnt vmcnt(0)" ::: "memory");
            const unsigned og = xb_add(&bar[XB_TOP], 1u);
            const unsigned tg = og / nx;
            if (og + 1u == (tg + 1u) * nx) xb_add(&bar[XB_TOPGEN], 1u);
            else XB_SPIN(xb_ld(&bar[XB_TOPGEN]) == tg, bar);
            __builtin_amdgcn_fence(__ATOMIC_ACQUIRE, "agent");
            xb_add(&bar[XB_XGEN(b.x)], 1u);
            asm volatile("s_waitcnt vmcnt(0)" ::: "memory");
        } else {
            XB_SPIN(xb_ld(&bar[XB_XGEN(b.x)]) == gen, bar);
            __builtin_amdgcn_fence(__ATOMIC_ACQUIRE, "agent");
            asm volatile("s_waitcnt vmcnt(0)" ::: "memory");
        }
    }
    __syncthreads();
}

__device__ __forceinline__ void sub_barrier(unsigned* ctr, unsigned n) {
    asm volatile("s_waitcnt vmcnt(0)" ::: "memory");
    __syncthreads();
    if (threadIdx.x == 0) {
        __builtin_amdgcn_fence(__ATOMIC_RELEASE, "agent");
        asm volatile("s_waitcnt vmcnt(0)" ::: "memory");
        (void)__hip_atomic_fetch_add(ctr, 1u, __ATOMIC_RELAXED, __HIP_MEMORY_SCOPE_AGENT);
        unsigned sp = 0u;
        while (__hip_atomic_load(ctr, __ATOMIC_RELAXED, __HIP_MEMORY_SCOPE_AGENT) < n) { __builtin_amdgcn_s_sleep(2); if (++sp > (1u << 22)) break; }
        __builtin_amdgcn_fence(__ATOMIC_ACQUIRE, "agent");
        asm volatile("s_waitcnt vmcnt(0)" ::: "memory");
    }
    __syncthreads();
}
constexpr int MIXA_C0 = 1536;
constexpr int SUBBAR_WORD = 8192;
constexpr int N_PHASES = 16;
constexpr int XB_LDS_OFF = LDS_BYTES - 64, XB_WS_WORD = 4096;
__global__ void __launch_bounds__(NTHREADS, 2) mega_fwd(Args args) {
    extern __shared__ __attribute__((aligned(16))) unsigned char lds_raw[];
    LAS unsigned char* lds0 = (LAS unsigned char*)lds_raw;
    const Args* ap0 = (const Args*)__builtin_amdgcn_kernarg_segment_ptr();
    const int ph_lo = ap0->ph_lo, ph_hi = ap0->ph_hi;
    if (ph_hi - ph_lo > 1) {
        volatile LAS unsigned* bst = (volatile LAS unsigned*)(lds0 + XB_LDS_OFF);
        if (threadIdx.x < 2) bst[threadIdx.x] = 0u;
        __syncthreads();
        (void)xcd_barrier_post((unsigned*)(ap0->ws) + XB_WS_WORD, bst);
    }
    for (int ph = ph_lo; ph < ph_hi; ++ph) {
        const Args* ap = ap0; asm volatile("" : "+s"(ap));
        const Args& A = *ap;
        int tid = threadIdx.x; asm volatile("" : "+v"(tid));
        int G = gridDim.x, bid = blockIdx.x; asm volatile("" : "+s"(G), "+s"(bid));
        LAS unsigned char* lds = lds0; asm volatile("" : "+s"(lds));
        const int lane = tid & 63, wave = __builtin_amdgcn_readfirstlane(tid >> 6);
        const int gw = bid * NWAVES + wave, NGW = G * NWAVES;
        unsigned char* ws = A.ws;
        bool is_gemm = false; pg8::Gemm g{nullptr, nullptr, 0, 0, 0}; pg8::EpiU E{nullptr, 0, 0}; int gG = G, gc = bid;
        switch (ph) {
        case 0: prologue<0>(A, lds, gw, NGW, wave, lane); break;
        case 1: g = pg8::Gemm{(const bf16*)(ws + WS_XN), (const bf16*)(ws + WS_W1IN), M_TOK, 2 * D_FF, D_MODEL}; E = pg8::EpiU{(bf16*)(ws + WS_HU), D_FF, 1}; is_gemm = true; break;
        case 2: g = pg8::Gemm{(const bf16*)(ws + WS_HU), (const bf16*)(ws + WS_W1OUT), M_TOK, D_MODEL, D_FF}; E = pg8::EpiU{(bf16*)(ws + WS_Y), D_MODEL, 0}; is_gemm = true; break;
        case 3: norm_pass<false, true>((const bf16*)(ws + WS_Y), A.in[I_X], ws + WS_HB, 0.5f, A.in[I_F1POST], A.in[I_MIXPRE], (bf16*)(ws + WS_XN), gw, NGW, lane); break;
        case 4: g = pg8::Gemm{(const bf16*)(ws + WS_XN), (const bf16*)(ws + WS_WMIXIN) + (size_t)MIXA_C0 * D_MODEL, M_TOK, LDU - MIXA_C0, D_MODEL}; E = pg8::EpiU{(bf16*)(ws + WS_HU) + MIXA_C0, LDU, 0}; is_gemm = true; break;
        case 5: { const int nR = (G >= 256) ? 128 : (G / 2 > 0 ? G / 2 : 1);
                  if (bid >= nR) { g = pg8::Gemm{(const bf16*)(ws + WS_XN), (const bf16*)(ws + WS_WMIXIN), M_TOK, MIXA_C0, D_MODEL}; E = pg8::EpiU{(bf16*)(ws + WS_HU), LDU, 0}; is_gemm = true; gG = G - nR; gc = bid - nR; } } break;
        case 6: {
            const bf16* HU = (const bf16*)(ws + WS_HU); bf16* XN = (bf16*)(ws + WS_Y);
            const int nR = (G >= 256) ? 128 : (G / 2 > 0 ? G / 2 : 1);
            if (bid < nR) { for (int hd = bid; hd < BATCH * 8; hd += nR) rwkv_head(lds, A, HU, XN, hd >> 3, hd & 7, tid); }
            else { if (ph_hi - ph_lo > 1) sub_barrier((unsigned*)(ws) + SUBBAR_WORD, (unsigned)(G - nR));
                   for (int u = bid - nR; u < BATCH * 8 * 8; u += G - nR) { const int bh = u & 127, qb = 7 - (u >> 7); sb_unit(lds, HU, XN, A.in[I_SBG], bh >> 3, bh & 7, qb, tid); }
                   __syncthreads();
                   { const int sb = bid - nR, nsb = G - nR;
                     if (nsb == 128) { if (sb < 64) prologue<1>(A, lds, sb * NWAVES + wave, 2048, wave, lane);
                                       else { for (int k = 0; k < 3; ++k) { prologue<1>(A, lds, 512 + ((sb - 64) * NWAVES + wave) * 3 + k, 2048, wave, lane); } } }
                     else prologue<1>(A, lds, sb * NWAVES + wave, nsb * NWAVES, wave, lane); }
                   __syncthreads();
                   g = pg8::Gemm{(const bf16*)(ws + WS_MEMN), (const bf16*)(ws + WS_WKV), M_MEM, D_MODEL, D_MODEL}; E = pg8::EpiU{(bf16*)(ws + WS_KVM), D_MODEL, 0}; is_gemm = true; gG = G - nR; gc = bid - nR; }
        } break;
        case 7: g = pg8::Gemm{(const bf16*)(ws + WS_Y), (const bf16*)(ws + WS_WMIXOUT), M_TOK, D_MODEL, D_MODEL}; E = pg8::EpiU{(bf16*)(ws + WS_XN), D_MODEL, 0}; is_gemm = true; break;
        case 8: norm_pass<true, true>((const bf16*)(ws + WS_XN), ws + WS_HB, ws + WS_HB, 1.0f, A.in[I_MIXPOST], A.in[I_MEMPRE], (bf16*)(ws + WS_XN), gw, NGW, lane); break;
        case 9: g = pg8::Gemm{(const bf16*)(ws + WS_XN), (const bf16*)(ws + WS_WQ), M_TOK, MEM_W, D_MODEL}; E = pg8::EpiU{(bf16*)(ws + WS_QM), MEM_W, 0}; is_gemm = true; break;
        case 10: for (int pu = bid; pu < BATCH * 4 * 4; pu += G) { const int bm = pu >> 2, q0 = pu & 3, b = bm >> 2, mh = bm & 3;
                     __syncthreads(); xatt_stage(lds, (const bf16*)(ws + WS_KVM), b, mh, tid); __syncthreads();
                     xatt_unit(lds, (const bf16*)(ws + WS_QM), (bf16*)(ws + WS_OM), b, mh, q0, tid); xatt_unit(lds, (const bf16*)(ws + WS_QM), (bf16*)(ws + WS_OM), b, mh, q0 + 4, tid); } break;
        case 11: g = pg8::Gemm{(const bf16*)(ws + WS_OM), (const bf16*)(ws + WS_WO), M_TOK, D_MODEL, MEM_W}; E = pg8::EpiU{(bf16*)(ws + WS_Y), D_MODEL, 0}; is_gemm = true; break;
        case 12: norm_pass<true, true>((const bf16*)(ws + WS_Y), ws + WS_HB, ws + WS_HB, 1.0f, A.in[I_MEMPOST], A.in[I_F2PRE], (bf16*)(ws + WS_XN), gw, NGW, lane); break;
        case 13: g = pg8::Gemm{(const bf16*)(ws + WS_XN), (const bf16*)(ws + WS_W2IN), M_TOK, 2 * D_FF, D_MODEL}; E = pg8::EpiU{(bf16*)(ws + WS_HU), D_FF, 1}; is_gemm = true; break;
        case 14: g = pg8::Gemm{(const bf16*)(ws + WS_HU), (const bf16*)(ws + WS_W2OUT), M_TOK, D_MODEL, D_FF}; E = pg8::EpiU{(bf16*)(ws + WS_Y), D_MODEL, 0}; is_gemm = true; break;
        case 15: norm_pass<true, false>((const bf16*)(ws + WS_Y), ws + WS_HB, A.out, 0.5f, A.in[I_F2POST], nullptr, nullptr, gw, NGW, lane); break;
        default: break;
        }
        if (is_gemm) { pg8::StaticOrder S; S.init(g.M, g.N, gG, gc); pg8::gemm_phase<pg8::EpiU, pg8::StaticOrder, true, true>(lds, g, S, E, tid); }
        if (ph + 1 < ph_hi && ph != 5) {
            if (ph_hi > N_PHASES) { __syncthreads(); cg::this_grid().sync(); }
            else { XcdBarrier xb; xb.bar = (unsigned*)(A.ws) + XB_WS_WORD; xb.x = xb_xcc_id(); xb.st = (volatile LAS unsigned*)(lds + XB_LDS_OFF); xcd_barrier(xb); }
        }
    }
}

#ifndef MK_ONE_LAUNCH
#define MK_ONE_LAUNCH 1
#endif
extern "C" void kernel_launch(void* const* d_in, const int* in_sizes, int n_in, void* d_out, int out_size, void* d_ws, size_t ws_size, hipStream_t stream) {
    static int grid = 0;
    if (grid == 0) {
        if (n_in != N_IN || out_size != M_TOK * D_MODEL || ws_size < WS_END) { fprintf(stderr, "kernel_launch: unexpected shapes (n_in %d out %d ws %zu)\n", n_in, out_size, ws_size); grid = -1; return; }
        int dev = 0, cus = 0, per_cu = 0;
        if (hipGetDevice(&dev) != hipSuccess || hipDeviceGetAttribute(&cus, hipDeviceAttributeMultiprocessorCount, dev) != hipSuccess) { grid = -1; return; }
        if (hipFuncSetAttribute((const void*)mega_fwd, hipFuncAttributeMaxDynamicSharedMemorySize, LDS_BYTES) != hipSuccess) { fprintf(stderr, "kernel_launch: hipFuncSetAttribute failed\n"); grid = -1; return; }
        if (hipOccupancyMaxActiveBlocksPerMultiprocessor(&per_cu, (const void*)mega_fwd, NTHREADS, LDS_BYTES) != hipSuccess || per_cu < 1) { fprintf(stderr, "kernel_launch: occupancy query gave %d\n", per_cu); per_cu = 1; }
        (void)hipGetLastError();
        grid = cus;
    }
    if (grid < 0) return;
    if (hipMemsetAsync(d_ws, 0, 1u << 20, stream) != hipSuccess) { fprintf(stderr, "kernel_launch: memset of the control words failed\n"); return; }
    Args a{};
    for (int i = 0; i < N_IN; ++i) a.in[i] = (const float*)d_in[i];
    a.out = (float*)d_out; a.ws = (unsigned char*)d_ws;
#if MK_ONE_LAUNCH
    a.ph_lo = 0; a.ph_hi = N_PHASES;
    void* kargs[] = {&a};
    hipError_t e = hipLaunchCooperativeKernel((const void*)mega_fwd, dim3(grid), dim3(NTHREADS), kargs, LDS_BYTES, stream);
    if (e != hipSuccess) fprintf(stderr, "cooperative launch failed: %s (grid %d)\n", hipGetErrorString(e), grid);
#else
    for (int p = 0; p < N_PHASES; ++p) { a.ph_lo = p; a.ph_hi = p + 1; hipLaunchKernelGGL(mega_fwd, dim3(grid), dim3(NTHREADS), LDS_BYTES, stream, a); }
#endif
}
```

```cpp
#include <hip/hip_runtime.h>
#include <hip/hip_cooperative_groups.h>
#include <cstdio>
#include <cstdint>
namespace cg = cooperative_groups;
namespace pg8 {
#define PG8_LAS __attribute__((address_space(3)))
typedef unsigned short bf16_t;
typedef short bf16x8 __attribute__((ext_vector_type(8)));
typedef float f32x4 __attribute__((ext_vector_type(4)));
typedef unsigned u32x4 __attribute__((ext_vector_type(4)));
constexpr int BM = 256, BK = 64, HALF = 128, HTB = HALF * BK * 2  , STAGE_BYTES = 8 * HTB, NXCD = 8, WGM = 8;

__host__ __device__ __forceinline__ int lds_byte(int r, int c) { const int st = (r >> 4) * 2 + (c >> 5), rr = r & 15, cc = c & 31, ob = rr * 64 + cc * 2; return st * 1024 + (ob ^ (((ob >> 9) & 1) << 5)); }
__host__ __device__ __forceinline__ void stage_rc(int b, int& R, int& C) { const int st = b / 1024, sb = b % 1024, swz = sb ^ (((sb >> 9) & 1) << 5); R = (st >> 1) * 16 + swz / 64; C = (st & 1) * 32 + (swz % 64) / 2; }
__host__ __device__ __forceinline__ int perm32(int rho) { const int n = rho >> 4, i = rho & 15; return 8 * (i >> 2) + 4 * n + (i & 3); }

struct Unit { int pm, pn; };
struct Gemm { const bf16_t* A; const bf16_t* Bt; int M, N, K; };

struct StaticOrder {
    int nM, nN, nwg, G, c;
    __host__ __device__ void init(int M, int N, int G_, int c_) { nM = M / BM; nN = N / BM; nwg = nM * nN; G = G_; c = c_; }
    __host__ __device__ bool next(int i, Unit& u) const {
        const long L = (long)i * G + c; if (L >= nwg) return false;
        int wgid = (int)L; { const int q = nwg / NXCD, r = nwg % NXCD, xcd = wgid % NXCD, off = wgid / NXCD; wgid = (xcd < r ? xcd * (q + 1) : r * (q + 1) + (xcd - r) * q) + off; }
        const int nig = WGM * nN, gid = wgid / nig, fm = gid * WGM, gsz = (nM - fm) < WGM ? (nM - fm) : WGM;
        u.pm = fm + ((wgid % nig) % gsz); u.pn = (wgid % nig) / gsz; return true;
    }
    __device__ __forceinline__ void a_ready(const Unit&) const {}
    __device__ __forceinline__ void done(const Unit&) const {}
};
__device__ __forceinline__ unsigned cvt_pk_bf16(float lo, float hi) { unsigned r; asm volatile("v_cvt_pk_bf16_f32 %0, %1, %2" : "=v"(r) : "v"(lo), "v"(hi)); return r; }
typedef float f32x2 __attribute__((ext_vector_type(2)));
struct EpiU {
    static constexpr bool PERM = true, AFTER_DRAIN = false;
    bf16_t* O; int ldc; int mode;
    __device__ __forceinline__ void operator()(const f32x4 (&acc)[2][2][4][2], const Unit& u, int wr, int wc, int fr, int fq) const {
        const int row0 = u.pm * BM + wr * 64 + fr;
        if (mode == 0) {
            const int col0 = u.pn * BM + wc * 32 + 8 * fq;
#pragma unroll
            for (int ai = 0; ai < 2; ++ai)
#pragma unroll
                for (int m = 0; m < 4; ++m) { bf16_t* rowp = O + (size_t)(row0 + ai * HALF + m * 16) * ldc + col0;
#pragma unroll
                    for (int bj = 0; bj < 2; ++bj) { const f32x4 v0 = acc[ai][bj][m][0], v1 = acc[ai][bj][m][1];
                        u32x4 w; w.x = cvt_pk_bf16(v0[0], v0[1]); w.y = cvt_pk_bf16(v0[2], v0[3]); w.z = cvt_pk_bf16(v1[0], v1[1]); w.w = cvt_pk_bf16(v1[2], v1[3]);
                        *(u32x4*)(rowp + bj * HALF) = w; } }
        } else {
            const int col0 = u.pn * HALF + wc * 32 + 8 * fq;
#pragma unroll
            for (int ai = 0; ai < 2; ++ai)
#pragma unroll
                for (int m = 0; m < 4; ++m) { bf16_t* rowp = O + (size_t)(row0 + ai * HALF + m * 16) * ldc + col0;
                    float hv[8];
#pragma unroll
                    for (int n = 0; n < 2; ++n)
#pragma unroll
                        for (int j = 0; j < 4; ++j) { const float g = acc[ai][0][m][n][j], up = acc[ai][1][m][n][j];
                            hv[4 * n + j] = g * __builtin_amdgcn_rcpf(1.f + __expf(-g)) * up; }
                    u32x4 w; w.x = cvt_pk_bf16(hv[0], hv[1]); w.y = cvt_pk_bf16(hv[2], hv[3]); w.z = cvt_pk_bf16(hv[4], hv[5]); w.w = cvt_pk_bf16(hv[6], hv[7]);
                    *(u32x4*)rowp = w; }
        }
    }
};
template <class Epi, class Sched, bool ALIGN_EPI = false, bool SP2 = false>
__device__ __forceinline__ void gemm_phase(PG8_LAS unsigned char* lds, const Gemm g, const Sched& S, const Epi& E, const int tid) {
    const int wid = __builtin_amdgcn_readfirstlane(tid >> 6), lane = tid & 63, wr = wid >> 2, wc = wid & 3, fr = lane & 15, fq = lane >> 4;
    const int K = g.K, nt = K / BK;
    unsigned voffA[2], voffB[2];
#pragma unroll
    for (int i = 0; i < 2; ++i) { int R, C; stage_rc(tid * 16 + i * 8192, R, C); const int Rb = Epi::PERM ? ((R & ~31) + perm32(R & 31)) : R;
        voffA[i] = (unsigned)(R * K + C) * 2u; voffB[i] = (unsigned)(Rb * K + C) * 2u; }
    const size_t kstep = (size_t)(BK * 2);
    const size_t hstep = (size_t)HALF * K * 2;
    const size_t tstep = 2 * hstep;
    const unsigned ldsw = (unsigned)wid * 1024u;
    const int aoff = lds_byte(wr * 64 + fr, fq * 8), boff = lds_byte(wc * 32 + fr, fq * 8);
#define PG8_SA(b, h) (((b) * 2 + (h)) * HTB)
#define PG8_SB(b, h) ((4 + (b) * 2 + (h)) * HTB)
#define PG8_STAGE(bufoff, gbase, voff) do { _Pragma("unroll") for (int _i = 0; _i < 2; ++_i) \
        __builtin_amdgcn_global_load_lds((const unsigned*)((const char*)(gbase) + (voff)[_i]), (PG8_LAS unsigned*)(lds + (bufoff) + ldsw + _i * 8192), 16, 0, 0); } while (0)
#define PG8_LDA(dst, b, h) do { _Pragma("unroll") for (int m = 0; m < 4; ++m) _Pragma("unroll") for (int k = 0; k < 2; ++k) dst[m][k] = *(const PG8_LAS bf16x8*)(lds + PG8_SA(b, h) + aoff + m * 2048 + k * 1024); } while (0)
#define PG8_LDB(dst, b, h) do { _Pragma("unroll") for (int n = 0; n < 2; ++n) _Pragma("unroll") for (int k = 0; k < 2; ++k) dst[n][k] = *(const PG8_LAS bf16x8*)(lds + PG8_SB(b, h) + boff + n * 2048 + k * 1024); } while (0)
#define PG8_MMA(ai, bj, At, Bt) do { __builtin_amdgcn_s_setprio(1); _Pragma("unroll") for (int m = 0; m < 4; ++m) _Pragma("unroll") for (int n = 0; n < 2; ++n) _Pragma("unroll") for (int k = 0; k < 2; ++k) \
        acc[ai][bj][m][n] = __builtin_amdgcn_mfma_f32_16x16x32_bf16(Bt[n][k], At[m][k], acc[ai][bj][m][n], 0, 0, 0); __builtin_amdgcn_s_setprio(0); } while (0)
#define PG8_WAIT_V(n) asm volatile("s_waitcnt vmcnt(" #n ")" ::: "memory")
#define PG8_WAIT_L(n) asm volatile("s_waitcnt lgkmcnt(" #n ")" ::: "memory")
#define PG8_BAR __builtin_amdgcn_s_barrier()
#define PG8_SCHED __builtin_amdgcn_sched_barrier(0)
    Unit cur, nxt; int ui = 0;
    if (!S.next(0, cur)) return;
    f32x4 acc[2][2][4][2];
#pragma unroll
    for (int a = 0; a < 2; ++a)
#pragma unroll
        for (int b = 0; b < 2; ++b)
#pragma unroll
            for (int m = 0; m < 4; ++m)
#pragma unroll
                for (int n = 0; n < 2; ++n) acc[a][b][m][n] = (f32x4){0.f, 0.f, 0.f, 0.f};
    bf16x8 At[4][2], B0[2][2], B1[2][2];
    const char* cA = (const char*)g.A + (size_t)cur.pm * tstep; const char* cB = (const char*)g.Bt + (size_t)cur.pn * tstep;
    S.a_ready(cur);
    if constexpr (SP2) {
        PG8_STAGE(PG8_SB(0, 0), cB, voffB); PG8_STAGE(PG8_SB(0, 1), cB + hstep, voffB); PG8_STAGE(PG8_SA(0, 0), cA, voffA); PG8_STAGE(PG8_SA(0, 1), cA + hstep, voffA);
        if (wr == 1) PG8_BAR;
        PG8_WAIT_V(2); PG8_BAR;
        PG8_STAGE(PG8_SB(1, 0), cB + kstep, voffB); PG8_STAGE(PG8_SA(1, 0), cA + kstep, voffA); PG8_STAGE(PG8_SB(1, 1), cB + hstep + kstep, voffB);
        PG8_WAIT_V(6); PG8_BAR;
    } else {
        PG8_STAGE(PG8_SB(0, 0), cB, voffB); PG8_STAGE(PG8_SA(0, 0), cA, voffA); PG8_STAGE(PG8_SB(0, 1), cB + hstep, voffB); PG8_STAGE(PG8_SA(0, 1), cA + hstep, voffA);
        if (wr == 1) PG8_BAR;
        PG8_WAIT_V(4); PG8_BAR;
        PG8_STAGE(PG8_SB(1, 0), cB + kstep, voffB); PG8_STAGE(PG8_SA(1, 0), cA + kstep, voffA); PG8_STAGE(PG8_SB(1, 1), cB + hstep + kstep, voffB);
        PG8_WAIT_V(6); PG8_BAR;
    }
    for (;;) {
        const bool has_next = S.next(ui + 1, nxt);
        const char* nA = has_next ? (const char*)g.A + (size_t)nxt.pm * tstep : cA; const char* nB = has_next ? (const char*)g.Bt + (size_t)nxt.pn * tstep : cB;
        for (int t = 0; t < nt; t += 2) {
            const bool last = (t == nt - 2);
            const char* a1 = cA + (size_t)(t + 1) * kstep;
            const char* a2 = last ? nA : cA + (size_t)(t + 2) * kstep; const char* b2 = last ? nB : cB + (size_t)(t + 2) * kstep;
            const char* a3 = a2 + kstep; const char* b3 = b2 + kstep;
            if (last && has_next) S.a_ready(nxt);
            if constexpr (SP2) {
            PG8_LDB(B0, 0, 0); PG8_LDB(B1, 0, 1); PG8_SCHED; PG8_LDA(At, 0, 0); PG8_STAGE(PG8_SA(1, 1), a1 + hstep, voffA);
            PG8_WAIT_V(8); PG8_WAIT_L(0); PG8_BAR; PG8_MMA(0, 0, At, B0); PG8_MMA(0, 1, At, B1); PG8_BAR; PG8_SCHED;
            PG8_LDA(At, 0, 1); PG8_STAGE(PG8_SB(0, 0), b2, voffB); PG8_STAGE(PG8_SB(0, 1), b2 + hstep, voffB); PG8_STAGE(PG8_SA(0, 0), a2, voffA);
            PG8_WAIT_V(8); PG8_WAIT_L(0); PG8_BAR; PG8_MMA(1, 0, At, B0); PG8_MMA(1, 1, At, B1); PG8_BAR; PG8_SCHED;
            PG8_LDB(B0, 1, 0); PG8_LDB(B1, 1, 1); PG8_SCHED; PG8_LDA(At, 1, 0); PG8_STAGE(PG8_SA(0, 1), a2 + hstep, voffA);
            PG8_WAIT_V(8); PG8_WAIT_L(0); PG8_BAR; PG8_MMA(0, 0, At, B0); PG8_MMA(0, 1, At, B1); PG8_BAR; PG8_SCHED;
            PG8_LDA(At, 1, 1); PG8_STAGE(PG8_SB(1, 0), b3, voffB); PG8_STAGE(PG8_SB(1, 1), b3 + hstep, voffB); PG8_STAGE(PG8_SA(1, 0), a3, voffA);
            PG8_WAIT_V(8); PG8_WAIT_L(0); PG8_BAR; PG8_MMA(1, 0, At, B0); PG8_MMA(1, 1, At, B1); PG8_BAR; PG8_SCHED;
            } else {
            PG8_LDB(B0, 0, 0); PG8_SCHED; PG8_LDA(At, 0, 0); PG8_STAGE(PG8_SA(1, 1), a1 + hstep, voffA);
            PG8_WAIT_L(8); PG8_BAR; PG8_WAIT_L(0); PG8_MMA(0, 0, At, B0); PG8_BAR; PG8_SCHED;
            PG8_LDB(B1, 0, 1); PG8_STAGE(PG8_SB(0, 0), b2, voffB);
            PG8_BAR; PG8_WAIT_L(0); PG8_MMA(0, 1, At, B1); PG8_BAR;
            PG8_LDA(At, 0, 1); PG8_STAGE(PG8_SA(0, 0), a2, voffA);
            PG8_BAR; PG8_WAIT_L(0); PG8_MMA(1, 0, At, B0); PG8_BAR; PG8_SCHED;
            PG8_STAGE(PG8_SB(0, 1), b2 + hstep, voffB);
            PG8_WAIT_V(6); PG8_BAR; PG8_MMA(1, 1, At, B1); PG8_BAR;
            PG8_LDB(B0, 1, 0); PG8_SCHED; PG8_LDA(At, 1, 0); PG8_STAGE(PG8_SA(0, 1), a2 + hstep, voffA);
            PG8_WAIT_L(8); PG8_BAR; PG8_WAIT_L(0); PG8_MMA(0, 0, At, B0); PG8_BAR; PG8_SCHED;
            PG8_LDB(B1, 1, 1); PG8_STAGE(PG8_SB(1, 0), b3, voffB);
            PG8_BAR; PG8_WAIT_L(0); PG8_MMA(0, 1, At, B1); PG8_BAR;
            PG8_LDA(At, 1, 1); PG8_STAGE(PG8_SA(1, 0), a3, voffA);
            PG8_BAR; PG8_WAIT_L(0); PG8_MMA(1, 0, At, B0); PG8_BAR; PG8_SCHED;
            PG8_STAGE(PG8_SB(1, 1), b3 + hstep, voffB);
            PG8_WAIT_V(6); PG8_BAR; PG8_MMA(1, 1, At, B1); PG8_BAR;
            }
        }
        if constexpr (ALIGN_EPI) { if (wr == 0) PG8_BAR; }
        if constexpr (!Epi::AFTER_DRAIN) { E(acc, cur, wr, wc, fr, fq); S.done(cur); }
        if (!has_next) break;
#pragma unroll
        for (int a = 0; a < 2; ++a)
#pragma unroll
            for (int b = 0; b < 2; ++b)
#pragma unroll
                for (int m = 0; m < 4; ++m)
#pragma unroll
                    for (int n = 0; n < 2; ++n) acc[a][b][m][n] = (f32x4){0.f, 0.f, 0.f, 0.f};
        cur = nxt; cA = nA; cB = nB; ++ui;
        if constexpr (ALIGN_EPI) { if (wr == 1) PG8_BAR; }
    }
    PG8_WAIT_V(0);
    if constexpr (!ALIGN_EPI) { if (wr == 0) PG8_BAR; }
    PG8_BAR;
    if constexpr (Epi::AFTER_DRAIN) { E.fused(acc, cur, wr, wc, fr, fq, lds, wid, lane); S.done(cur); }
#undef PG8_SA
#undef PG8_SB
#undef PG8_STAGE
#undef PG8_LDA
#undef PG8_LDB
#undef PG8_MMA
#undef PG8_WAIT_V
#undef PG8_WAIT_L
#undef PG8_BAR
#undef PG8_SCHED
}
}

constexpr int D_MODEL = 1024, BATCH = 16, SEQ = 2048, M_TOK = BATCH * SEQ;
constexpr int MEM_LEN = 256, M_MEM = BATCH * MEM_LEN;
constexpr int D_FF = 2816, MIX_IN = 3360, LDU = 3584, RW_OFF = 1536, RWKV_IN = 1824;
constexpr int MEM_W = 512;
constexpr float NORM_EPS = 1e-6f, LNX_EPS = 64e-5f;
constexpr int NWAVES = 8, NTHREADS = 512;
constexpr int LDS_BYTES = 147456;
enum { I_X = 0, I_MEM, I_F1PRE, I_F1POST, I_F1WIN, I_F1WOUT, I_MIXPRE, I_MIXPOST, I_MIXWIN, I_MU, I_W0, I_W2, I_A0, I_A2, I_G2, I_KK, I_KA, I_RK, I_LNG, I_LNB,
       I_SBG, I_MIXWOUT, I_MEMPRE, I_MEMPOST, I_MEMKVG, I_WQ, I_WKV, I_WO, I_F2PRE, I_F2POST, I_F2WIN, I_F2WOUT, N_IN };
constexpr size_t MiB = 1u << 20;
constexpr size_t WS_W1IN = 2 * MiB, WS_W1OUT = 13 * MiB, WS_WMIXIN = 19 * MiB, WS_WMIXOUT = 26 * MiB, WS_WQ = 28 * MiB, WS_WKV = 29 * MiB, WS_WO = 31 * MiB,
                 WS_W2IN = 32 * MiB, WS_W2OUT = 43 * MiB, WS_LW2 = 49 * MiB, WS_LA2 = WS_LW2 + 65536, WS_LG2 = WS_LA2 + 65536,
                 WS_MEMN = 56 * MiB, WS_KVM = 64 * MiB, WS_XN = 72 * MiB, WS_Y = 136 * MiB, WS_HU = 200 * MiB, WS_HB = 424 * MiB, WS_END = 488 * MiB;
constexpr size_t WS_QM = WS_HU, WS_OM = WS_HU + 32 * MiB;

#define LAS __attribute__((address_space(3)))
typedef unsigned short bf16;
typedef short bf16x8 __attribute__((ext_vector_type(8)));
typedef short s16x4 __attribute__((ext_vector_type(4)));
typedef float f32x4 __attribute__((ext_vector_type(4)));
typedef float f32x2 __attribute__((ext_vector_type(2)));
typedef float f32x16 __attribute__((ext_vector_type(16)));
typedef unsigned u32x4 __attribute__((ext_vector_type(4)));
typedef unsigned u32x2 __attribute__((ext_vector_type(2)));

__device__ __forceinline__ float bflo(unsigned u) { return __uint_as_float(u << 16); }
__device__ __forceinline__ float bfhi(unsigned u) { return __uint_as_float(u & 0xffff0000u); }
__device__ __forceinline__ unsigned pk2(float lo, float hi) { return pg8::cvt_pk_bf16(lo, hi); }
template <int CTRL> __device__ __forceinline__ float dppf(float x) { return __builtin_bit_cast(float, __builtin_amdgcn_mov_dpp(__builtin_bit_cast(int, x), CTRL, 0xf, 0xf, true)); }
__device__ __forceinline__ float red16(float x) { x += dppf<0xB1>(x); x += dppf<0x4E>(x); x += dppf<0x141>(x); x += dppf<0x140>(x); return x; }
__device__ __forceinline__ float half_sum(float x) { auto t = __builtin_amdgcn_permlane32_swap(__float_as_uint(x), __float_as_uint(x), false, false); return __uint_as_float(t[0]) + __uint_as_float(t[1]); }
__device__ __forceinline__ float half_max(float x) { auto t = __builtin_amdgcn_permlane32_swap(__float_as_uint(x), __float_as_uint(x), false, false); return fmaxf(__uint_as_float(t[0]), __uint_as_float(t[1])); }
__device__ __forceinline__ float half_other(float x, int hi) { auto t = __builtin_amdgcn_permlane32_swap(__float_as_uint(x), __float_as_uint(x), false, false); return hi ? __uint_as_float(t[0]) : __uint_as_float(t[1]); }
__device__ __forceinline__ float wave_sum(float v) {
    v = red16(v);
    auto s = __builtin_amdgcn_permlane16_swap(__float_as_uint(v), __float_as_uint(v), false, false);
    v = __uint_as_float(s[0]) + __uint_as_float(s[1]);
    return half_sum(v);
}
#define LDS_BARRIER() do { asm volatile("s_waitcnt lgkmcnt(0)" ::: "memory"); __builtin_amdgcn_s_barrier(); asm volatile("" ::: "memory"); } while (0)
#define MFMA32(a, b, c) __builtin_amdgcn_mfma_f32_32x32x16_bf16((a), (b), (c), 0, 0, 0)

struct Args { const float* in[N_IN]; float* out; unsigned char* ws; int ph_lo, ph_hi; };

__device__ __forceinline__ void transpose_item(const float* W, int K, int N, bf16* WT, int ldk, int k0, int n0, int drow0, LAS float* scr, int lane) {
    float tv[32];
#pragma unroll
    for (int i = 0; i < 32; ++i) { const int k = k0 + 2 * i + (lane >> 5); tv[i] = (k < K) ? W[(size_t)k * N + n0 + (lane & 31)] : 0.f; }
#pragma unroll
    for (int i = 0; i < 32; ++i) scr[(2 * i + (lane >> 5)) * 33 + (lane & 31)] = tv[i];
    asm volatile("s_waitcnt lgkmcnt(0)" ::: "memory");
    const int c = lane & 7;
#pragma unroll
    for (int j = 0; j < 4; ++j) { const int n = (lane >> 3) + 8 * j; const LAS float* s = scr + (8 * c) * 33 + n;
        u32x4 o; o.x = pk2(s[0 * 33], s[1 * 33]); o.y = pk2(s[2 * 33], s[3 * 33]); o.z = pk2(s[4 * 33], s[5 * 33]); o.w = pk2(s[6 * 33], s[7 * 33]);
        if (k0 + 8 * c + 8 <= ldk) *(u32x4*)(WT + (size_t)(drow0 + n) * ldk + k0 + 8 * c) = o; }
    asm volatile("s_waitcnt lgkmcnt(0)" ::: "memory");
}
__device__ __forceinline__ void transpose_matrix_item(const float* W, int K, int N, bf16* WT, int ldk, int mode, int item, LAS float* scr, int lane) {
    const int nblk = N / 32, kb = item / nblk, nb = item % nblk, n0 = 32 * nb;
    int drow0 = n0;
    if (mode == 1) { drow0 = (n0 < D_FF) ? (n0 / 128) * 256 + (n0 % 128) : ((n0 - D_FF) / 128) * 256 + 128 + ((n0 - D_FF) % 128); }
    transpose_item(W, K, N, WT, ldk, 64 * kb, n0, drow0, scr, lane);
}
__device__ __forceinline__ void rms_rows2_to_bf16(const float* xrow, const float* g, bf16* orow, int lane) {
    const f32x4* gr = (const f32x4*)g + lane;
    f32x4 v[2][4]; float s[2] = {0.f, 0.f};
#pragma unroll
    for (int q = 0; q < 2; ++q) { const f32x4* xr = (const f32x4*)(xrow + (size_t)q * D_MODEL) + lane;
#pragma unroll
        for (int j = 0; j < 4; ++j) v[q][j] = xr[64 * j]; }
#pragma unroll
    for (int q = 0; q < 2; ++q)
#pragma unroll
        for (int j = 0; j < 4; ++j) s[q] += (v[q][j].x * v[q][j].x + v[q][j].y * v[q][j].y) + (v[q][j].z * v[q][j].z + v[q][j].w * v[q][j].w);
#pragma unroll
    for (int q = 0; q < 2; ++q) {
        const float rs = rsqrtf(wave_sum(s[q]) * (1.f / D_MODEL) + NORM_EPS);
        u32x2* o8 = (u32x2*)(orow + (size_t)q * D_MODEL) + lane;
#pragma unroll
        for (int j = 0; j < 4; ++j) { const f32x4 gg = gr[64 * j]; u32x2 o; o.x = pk2(v[q][j].x * rs * gg.x, v[q][j].y * rs * gg.y); o.y = pk2(v[q][j].z * rs * gg.z, v[q][j].w * rs * gg.w); o8[64 * j] = o; }
    }
}
template <int PART>
__device__ __forceinline__ void prologue(const Args& a, LAS unsigned char* lds, int gw, int NGW, int wave, int lane) {
    LAS float* scr = (LAS float*)(lds + wave * 16384);
    unsigned char* ws = a.ws;
    constexpr int I_FIN = (D_MODEL / 64) * (2 * D_FF / 32), I_FOUT = (D_FF / 64) * (D_MODEL / 32), I_MIN = (D_MODEL / 64) * (MIX_IN / 32), I_SQ = (D_MODEL / 64) * (D_MODEL / 32),
                  I_Q = (D_MODEL / 64) * (MEM_W / 32), I_O = (MEM_W / 64) * (D_MODEL / 32), I_L64 = 16, I_L160 = 48;
    if (PART == 0) {
        constexpr int NITEMS = I_FIN + I_FOUT + I_MIN + I_SQ + 2 * I_L64 + I_L160;
        for (int it = gw; it < NITEMS; it += NGW) {
            int r = it;
            if (r < I_FIN) { transpose_matrix_item(a.in[I_F1WIN], D_MODEL, 2 * D_FF, (bf16*)(ws + WS_W1IN), D_MODEL, 1, r, scr, lane); continue; } r -= I_FIN;
            if (r < I_FOUT) { transpose_matrix_item(a.in[I_F1WOUT], D_FF, D_MODEL, (bf16*)(ws + WS_W1OUT), D_FF, 0, r, scr, lane); continue; } r -= I_FOUT;
            if (r < I_MIN) { transpose_matrix_item(a.in[I_MIXWIN], D_MODEL, MIX_IN, (bf16*)(ws + WS_WMIXIN), D_MODEL, 0, r, scr, lane); continue; } r -= I_MIN;
            if (r < I_SQ) { transpose_matrix_item(a.in[I_WKV], D_MODEL, D_MODEL, (bf16*)(ws + WS_WKV), D_MODEL, 0, r, scr, lane); continue; } r -= I_SQ;
            if (r < I_L64) { transpose_matrix_item(a.in[I_W2], 64, 512, (bf16*)(ws + WS_LW2), 64, 0, r, scr, lane); continue; } r -= I_L64;
            if (r < I_L64) { transpose_matrix_item(a.in[I_A2], 64, 512, (bf16*)(ws + WS_LA2), 64, 0, r, scr, lane); continue; } r -= I_L64;
            transpose_matrix_item(a.in[I_G2], 160, 512, (bf16*)(ws + WS_LG2), 160, 0, r, scr, lane);
        }
        { u32x4* z = (u32x4*)((bf16*)(ws + WS_WMIXIN) + (size_t)MIX_IN * D_MODEL); const int n16 = (LDU - MIX_IN) * D_MODEL * 2 / 16;
          for (int i = gw * 64 + lane; i < n16; i += NGW * 64) z[i] = (u32x4){0u, 0u, 0u, 0u}; }
        for (int m = 2 * gw; m < M_TOK; m += 2 * NGW) rms_rows2_to_bf16(a.in[I_X] + (size_t)m * D_MODEL, a.in[I_F1PRE], (bf16*)(ws + WS_XN) + (size_t)m * D_MODEL, lane);
        for (int m = 2 * gw; m < M_MEM; m += 2 * NGW) rms_rows2_to_bf16(a.in[I_MEM] + (size_t)m * D_MODEL, a.in[I_MEMKVG], (bf16*)(ws + WS_MEMN) + (size_t)m * D_MODEL, lane);
    } else {
        constexpr int NITEMS = I_FIN + I_FOUT + I_SQ + I_Q + I_O;
        for (int it = gw; it < NITEMS; it += NGW) {
            int r = it;
            if (r < I_SQ) { transpose_matrix_item(a.in[I_MIXWOUT], D_MODEL, D_MODEL, (bf16*)(ws + WS_WMIXOUT), D_MODEL, 0, r, scr, lane); continue; } r -= I_SQ;
            if (r < I_Q) { transpose_matrix_item(a.in[I_WQ], D_MODEL, MEM_W, (bf16*)(ws + WS_WQ), D_MODEL, 0, r, scr, lane); continue; } r -= I_Q;
            if (r < I_O) { transpose_matrix_item(a.in[I_WO], MEM_W, D_MODEL, (bf16*)(ws + WS_WO), MEM_W, 0, r, scr, lane); continue; } r -= I_O;
            if (r < I_FIN) { transpose_matrix_item(a.in[I_F2WIN], D_MODEL, 2 * D_FF, (bf16*)(ws + WS_W2IN), D_MODEL, 1, r, scr, lane); continue; } r -= I_FIN;
            transpose_matrix_item(a.in[I_F2WOUT], D_FF, D_MODEL, (bf16*)(ws + WS_W2OUT), D_FF, 0, r, scr, lane);
        }
    }
}
template <bool HIN_BF, bool HOUT_BF>
__device__ __forceinline__ void norm_pass(const bf16* Y, const void* hin_, void* hout_, float coef, const float* gpost, const float* gpre, bf16* XN, int gw, int NGW, int lane) {
    f32x4 gp[4], gq[4];
#pragma unroll
    for (int j = 0; j < 4; ++j) { gp[j] = ((const f32x4*)gpost + lane)[64 * j]; gq[j] = gpre ? ((const f32x4*)gpre + lane)[64 * j] : (f32x4){0.f, 0.f, 0.f, 0.f}; }
    u32x2 ry[2][4]; u32x2 rhb[2][4]; f32x4 rhf[2][4];
#define NP_LOAD(r0) do { _Pragma("unroll") for (int q = 0; q < 2; ++q) { \
        const u32x2* yr = (const u32x2*)(Y + (size_t)((r0) + q) * D_MODEL) + lane; \
        _Pragma("unroll") for (int j = 0; j < 4; ++j) ry[q][j] = yr[64 * j]; \
        if (HIN_BF) { const u32x2* hr = (const u32x2*)((const bf16*)hin_ + (size_t)((r0) + q) * D_MODEL) + lane; _Pragma("unroll") for (int j = 0; j < 4; ++j) rhb[q][j] = hr[64 * j]; } \
        else { const f32x4* hr = (const f32x4*)((const float*)hin_ + (size_t)((r0) + q) * D_MODEL) + lane; _Pragma("unroll") for (int j = 0; j < 4; ++j) rhf[q][j] = hr[64 * j]; } } } while (0)
    int row0 = 2 * gw;
    if (row0 < M_TOK) NP_LOAD(row0);
    for (; row0 < M_TOK; row0 += 2 * NGW) {
        f32x4 y[2][4], h[2][4]; float s[2] = {0.f, 0.f};
#pragma unroll
        for (int q = 0; q < 2; ++q)
#pragma unroll
            for (int j = 0; j < 4; ++j) { const u32x2 t = ry[q][j]; y[q][j] = (f32x4){bflo(t.x), bfhi(t.x), bflo(t.y), bfhi(t.y)};
                if (HIN_BF) { const u32x2 u = rhb[q][j]; h[q][j] = (f32x4){bflo(u.x), bfhi(u.x), bflo(u.y), bfhi(u.y)}; } else h[q][j] = rhf[q][j]; }
        if (row0 + 2 * NGW < M_TOK) NP_LOAD(row0 + 2 * NGW);
#pragma unroll
        for (int q = 0; q < 2; ++q)
#pragma unroll
            for (int j = 0; j < 4; ++j) s[q] += (y[q][j].x * y[q][j].x + y[q][j].y * y[q][j].y) + (y[q][j].z * y[q][j].z + y[q][j].w * y[q][j].w);
#pragma unroll
        for (int q = 0; q < 2; ++q) {
            const float rs = rsqrtf(wave_sum(s[q]) * (1.f / D_MODEL) + NORM_EPS) * coef;
            float s2 = 0.f;
#pragma unroll
            for (int j = 0; j < 4; ++j) { h[q][j] = h[q][j] + y[q][j] * rs * gp[j];
                s2 += (h[q][j].x * h[q][j].x + h[q][j].y * h[q][j].y) + (h[q][j].z * h[q][j].z + h[q][j].w * h[q][j].w); }
            if (HOUT_BF) { u32x2* orow = (u32x2*)((bf16*)hout_ + (size_t)(row0 + q) * D_MODEL) + lane;
#pragma unroll
                for (int j = 0; j < 4; ++j) { u32x2 o; o.x = pk2(h[q][j].x, h[q][j].y); o.y = pk2(h[q][j].z, h[q][j].w); orow[64 * j] = o; } }
            else { f32x4* orow = (f32x4*)((float*)hout_ + (size_t)(row0 + q) * D_MODEL) + lane;
#pragma unroll
                for (int j = 0; j < 4; ++j) orow[64 * j] = h[q][j]; }
            if (gpre) {
                const float rs2 = rsqrtf(wave_sum(s2) * (1.f / D_MODEL) + NORM_EPS);
                u32x2* o8 = (u32x2*)(XN + (size_t)(row0 + q) * D_MODEL) + lane;
#pragma unroll
                for (int j = 0; j < 4; ++j) { const f32x4 g = gq[j]; u32x2 o; o.x = pk2(h[q][j].x * rs2 * g.x, h[q][j].y * rs2 * g.y); o.y = pk2(h[q][j].z * rs2 * g.z, h[q][j].w * rs2 * g.w); o8[64 * j] = o; }
            }
        }
    }
#undef NP_LOAD
}
constexpr int SB_KP = 72, SB_VP = 72;
typedef short v4i16_t __attribute__((ext_vector_type(4)));
__device__ __forceinline__ s16x4 lds_tr16(const LAS bf16* p) { return __builtin_bit_cast(s16x4, __builtin_amdgcn_ds_read_tr16_b64_v4i16((LAS v4i16_t*)p)); }
__device__ __forceinline__ void sb_unit(LAS unsigned char* lds, const bf16* U, bf16* MIX, const float* sbg, int b, int h, int qb, const int tid) {
    const int wave = tid >> 6, lane = tid & 63, j = lane & 31, hi = lane >> 5;
    LAS bf16* Ks = (LAS bf16*)lds;
    LAS bf16* Vt = (LAS bf16*)(lds + 64 * SB_KP * 2);
    const int qw = 256 * qb + 32 * wave;
    const size_t rowbase = (size_t)b * SEQ;
    bf16x8 qf[4];
    { const bf16* qp = U + (rowbase + qw + j) * LDU + h * 64 + 8 * hi;
#pragma unroll
      for (int ks = 0; ks < 4; ++ks) { const u32x4 raw = *(const u32x4*)(qp + 16 * ks); u32x4 sc;
          const float qs = 0.125f * 1.4426950408889634f;
          sc.x = pk2(bflo(raw.x) * qs, bfhi(raw.x) * qs); sc.y = pk2(bflo(raw.y) * qs, bfhi(raw.y) * qs);
          sc.z = pk2(bflo(raw.z) * qs, bfhi(raw.z) * qs); sc.w = pk2(bflo(raw.w) * qs, bfhi(raw.w) * qs);
          qf[ks] = __builtin_bit_cast(bf16x8, sc); } }
    f32x16 o0, o1;
#pragma unroll
    for (int r = 0; r < 16; ++r) { o0[r] = 0.f; o1[r] = 0.f; }
    float carry = 1.f;
    const int st_key = tid >> 3, st_dg = tid & 7;
    const bf16* kp0 = U + (rowbase + st_key) * LDU + 512 + h * 64 + 8 * st_dg;
    u32x4 kv = *(const u32x4*)(kp0 + (size_t)(64 * (4 * qb + 3)) * LDU), vv = *(const u32x4*)(kp0 + (size_t)(64 * (4 * qb + 3)) * LDU + 512);
    for (int jt = 4 * qb + 3; jt >= 0; --jt) {
        LDS_BARRIER();
        { *(LAS u32x4*)(Ks + st_key * SB_KP + 8 * st_dg) = kv;
          *(LAS u32x4*)(Vt + st_key * SB_VP + 8 * st_dg) = vv; }
        LDS_BARRIER();
        if (jt > 0) { kv = *(const u32x4*)(kp0 + (size_t)(64 * (jt - 1)) * LDU); vv = *(const u32x4*)(kp0 + (size_t)(64 * (jt - 1)) * LDU + 512); }
#pragma unroll 1
        for (int sub = 1; sub >= 0; --sub) {
            const int kbase = 64 * jt + 32 * sub;
            if (kbase > qw) continue;
            f32x16 acc;
#pragma unroll
            for (int r = 0; r < 16; ++r) acc[r] = 0.f;
#pragma unroll
            for (int ks = 0; ks < 4; ++ks) { const bf16x8 a = *(const LAS bf16x8*)(Ks + (32 * sub + j) * SB_KP + 16 * ks + 8 * hi); acc = MFMA32(a, qf[ks], acc); }
            const bool diag = (kbase == qw);
            float e[16], incl[16];
#pragma unroll
            for (int r = 0; r < 16; ++r) { const int i = 8 * (r >> 2) + 4 * hi + (r & 3); const float z = fminf(acc[r], 115.f);
                float ev = __builtin_amdgcn_exp2f(z); float dv = __builtin_amdgcn_rcpf(1.f + ev);
                if (diag && i >= j) { ev = 0.f; dv = 1.f; }
                e[r] = ev; incl[r] = dv; }
            float GP[4], GPo[4];
#pragma unroll
            for (int g = 0; g < 4; ++g) { incl[4 * g + 2] *= incl[4 * g + 3]; incl[4 * g + 1] *= incl[4 * g + 2]; incl[4 * g] *= incl[4 * g + 1]; GP[g] = incl[4 * g]; GPo[g] = half_other(GP[g], hi); }
            float ma[4], oi[4], base[4];
            ma[3] = 1.f; ma[2] = GP[3]; ma[1] = GP[2] * ma[2]; ma[0] = GP[1] * ma[1];
            oi[3] = GPo[3]; oi[2] = GPo[2] * oi[3]; oi[1] = GPo[1] * oi[2]; oi[0] = GPo[0] * oi[1];
            base[0] = carry * ma[0] * (hi ? oi[1] : oi[0]); base[1] = carry * ma[1] * (hi ? oi[2] : oi[1]);
            base[2] = carry * ma[2] * (hi ? oi[3] : oi[2]); base[3] = carry * ma[3] * (hi ? 1.f : oi[3]);
            carry = carry * ((GP[0] * ma[0]) * oi[0]);
            u32x4 p0, p1;
            p0.x = pk2(e[0] * incl[0] * base[0], e[1] * incl[1] * base[0]); p0.y = pk2(e[2] * incl[2] * base[0], e[3] * incl[3] * base[0]);
            p0.z = pk2(e[4] * incl[4] * base[1], e[5] * incl[5] * base[1]); p0.w = pk2(e[6] * incl[6] * base[1], e[7] * incl[7] * base[1]);
            p1.x = pk2(e[8] * incl[8] * base[2], e[9] * incl[9] * base[2]); p1.y = pk2(e[10] * incl[10] * base[2], e[11] * incl[11] * base[2]);
            p1.z = pk2(e[12] * incl[12] * base[3], e[13] * incl[13] * base[3]); p1.w = pk2(e[14] * incl[14] * base[3], e[15] * incl[15] * base[3]);
            const bf16x8 pa0 = __builtin_bit_cast(bf16x8, p0), pa1 = __builtin_bit_cast(bf16x8, p1);
#pragma unroll
            for (int s = 0; s < 2; ++s) {
                const bf16x8 pb = s ? pa1 : pa0;
                const LAS bf16* vp = Vt + (32 * sub + 16 * s + 4 * hi + ((lane & 15) >> 2)) * SB_VP + 16 * ((lane >> 4) & 1) + 4 * (lane & 3);
                { const s16x4 lo = lds_tr16(vp), hh = lds_tr16(vp + 8 * SB_VP); const bf16x8 va = __builtin_shufflevector(lo, hh, 0, 1, 2, 3, 4, 5, 6, 7); o0 = MFMA32(va, pb, o0); }
                { const s16x4 lo = lds_tr16(vp + 32), hh = lds_tr16(vp + 8 * SB_VP + 32); const bf16x8 va = __builtin_shufflevector(lo, hh, 0, 1, 2, 3, 4, 5, 6, 7); o1 = MFMA32(va, pb, o1); }
            }
        }
    }
    float ss = 0.f;
#pragma unroll
    for (int r = 0; r < 16; ++r) ss += o0[r] * o0[r] + o1[r] * o1[r];
    ss = half_sum(ss);
    const float rs = rsqrtf(ss * (1.f / 64.f) + NORM_EPS);
    bf16* op = MIX + (rowbase + qw + j) * D_MODEL + h * 64 + 4 * hi;
    const float* gp = sbg + h * 64 + 4 * hi;
#pragma unroll
    for (int g = 0; g < 4; ++g) {
        const f32x4 g0 = *(const f32x4*)(gp + 8 * g), g1 = *(const f32x4*)(gp + 32 + 8 * g);
        u32x2 w0, w1;
        w0.x = pk2(o0[4 * g] * rs * g0.x, o0[4 * g + 1] * rs * g0.y); w0.y = pk2(o0[4 * g + 2] * rs * g0.z, o0[4 * g + 3] * rs * g0.w);
        w1.x = pk2(o1[4 * g] * rs * g1.x, o1[4 * g + 1] * rs * g1.y); w1.y = pk2(o1[4 * g + 2] * rs * g1.z, o1[4 * g + 3] * rs * g1.w);
        *(u32x2*)(op + 8 * g) = w0; *(u32x2*)(op + 32 + 8 * g) = w1;
    }
}

constexpr int XA_KP = 136, XA_VP = 136;
__device__ __forceinline__ void xatt_stage(LAS unsigned char* lds, const bf16* KVm, int b, int mh, const int tid) {
    LAS bf16* Ks = (LAS bf16*)lds;
    LAS bf16* Vt = (LAS bf16*)(lds + 256 * XA_KP * 2);
    const bf16* base = KVm + (size_t)b * MEM_LEN * D_MODEL + mh * 128;
    u32x4 kv[8];
#pragma unroll
    for (int i = 0; i < 8; ++i) { const int p = tid + 512 * i, key = p >> 4, dg = p & 15; kv[i] = *(const u32x4*)(base + (size_t)key * D_MODEL + 8 * dg); }
#pragma unroll
    for (int i = 0; i < 8; ++i) { const int p = tid + 512 * i, key = p >> 4, dg = p & 15; *(LAS u32x4*)(Ks + key * XA_KP + 8 * dg) = kv[i]; }
#pragma unroll
    for (int i = 0; i < 8; ++i) { const int p = tid + 512 * i, key = p >> 4, dg = p & 15; kv[i] = *(const u32x4*)(base + (size_t)key * D_MODEL + 512 + 8 * dg); }
#pragma unroll
    for (int i = 0; i < 8; ++i) { const int p = tid + 512 * i, key = p >> 4, dg = p & 15; *(LAS u32x4*)(Vt + key * XA_VP + 8 * dg) = kv[i]; }
}
__device__ __forceinline__ void xatt_unit(LAS unsigned char* lds, const bf16* Qm, bf16* Om, int b, int mh, int qb, const int tid) {
    const int wave = tid >> 6, lane = tid & 63, j = lane & 31, hi = lane >> 5;
    LAS bf16* Ks = (LAS bf16*)lds;
    LAS bf16* Vt = (LAS bf16*)(lds + 256 * XA_KP * 2);
    const int qw = 256 * qb + 32 * wave;
    const size_t qrow = (size_t)b * SEQ + qw + j;
    bf16x8 qf[8];
    { const bf16* qp = Qm + qrow * MEM_W + mh * 128 + 8 * hi;
#pragma unroll
      for (int ks = 0; ks < 8; ++ks) qf[ks] = *(const bf16x8*)(qp + 16 * ks); }
    f32x16 o[4];
#pragma unroll
    for (int t = 0; t < 4; ++t)
#pragma unroll
        for (int r = 0; r < 16; ++r) o[t][r] = 0.f;
    float mrun = -1e30f, lsum = 0.f;
    const float scale = 0.08838834764831845f;
#pragma unroll 1
    for (int sub = 0; sub < 8; ++sub) {
        f32x16 acc;
#pragma unroll
        for (int r = 0; r < 16; ++r) acc[r] = 0.f;
#pragma unroll
        for (int ks = 0; ks < 8; ++ks) { const bf16x8 a = *(const LAS bf16x8*)(Ks + (32 * sub + j) * XA_KP + 16 * ks + 8 * hi); acc = MFMA32(a, qf[ks], acc); }
        float mx = -1e30f;
#pragma unroll
        for (int r = 0; r < 16; ++r) { acc[r] *= scale; mx = fmaxf(mx, acc[r]); }
        mx = half_max(mx);
        const float mnew = fmaxf(mrun, mx), corr = __expf(mrun - mnew);
        mrun = mnew; lsum *= corr;
        float p[16];
#pragma unroll
        for (int r = 0; r < 16; ++r) { p[r] = __expf(acc[r] - mnew); lsum += p[r]; }
#pragma unroll
        for (int t = 0; t < 4; ++t)
#pragma unroll
            for (int r = 0; r < 16; ++r) o[t][r] *= corr;
        u32x4 p0, p1;
        p0.x = pk2(p[0], p[1]); p0.y = pk2(p[2], p[3]); p0.z = pk2(p[4], p[5]); p0.w = pk2(p[6], p[7]);
        p1.x = pk2(p[8], p[9]); p1.y = pk2(p[10], p[11]); p1.z = pk2(p[12], p[13]); p1.w = pk2(p[14], p[15]);
        const bf16x8 pa0 = __builtin_bit_cast(bf16x8, p0), pa1 = __builtin_bit_cast(bf16x8, p1);
#pragma unroll
        for (int s = 0; s < 2; ++s) {
            const bf16x8 pb = s ? pa1 : pa0;
#pragma unroll
            for (int t = 0; t < 4; ++t) {
                const LAS bf16* vp = Vt + (32 * sub + 16 * s + 4 * hi + ((lane & 15) >> 2)) * XA_VP + 32 * t + 16 * ((lane >> 4) & 1) + 4 * (lane & 3);
                const s16x4 lo = lds_tr16(vp), hh = lds_tr16(vp + 8 * XA_VP); const bf16x8 va = __builtin_shufflevector(lo, hh, 0, 1, 2, 3, 4, 5, 6, 7);
                o[t] = MFMA32(va, pb, o[t]);
            }
        }
    }
    lsum = half_sum(lsum);
    const float inv = 1.f / lsum;
    bf16* op = Om + qrow * MEM_W + mh * 128 + 4 * hi;
#pragma unroll
    for (int t = 0; t < 4; ++t)
#pragma unroll
        for (int g = 0; g < 4; ++g) { u32x2 w; w.x = pk2(o[t][4 * g] * inv, o[t][4 * g + 1] * inv); w.y = pk2(o[t][4 * g + 2] * inv, o[t][4 * g + 3] * inv); *(u32x2*)(op + 32 * t + 8 * g) = w; }
}

constexpr int RW_P = 68;
constexpr int RW_ARR = 32 * RW_P * 4;
constexpr int RW_XWP = 72, RW_XGP = 168;
__device__ __forceinline__ void rw_lerp8(const u32x4 cu, const u32x4 pr, const LAS float* mu, float (&v)[8]) {
    const f32x4 m0 = *(const LAS f32x4*)mu, m1 = *(const LAS f32x4*)(mu + 4);
    float x, p;
    x = bflo(cu.x); p = bflo(pr.x); v[0] = x + (p - x) * m0.x;  x = bfhi(cu.x); p = bfhi(pr.x); v[1] = x + (p - x) * m0.y;
    x = bflo(cu.y); p = bflo(pr.y); v[2] = x + (p - x) * m0.z;  x = bfhi(cu.y); p = bfhi(pr.y); v[3] = x + (p - x) * m0.w;
    x = bflo(cu.z); p = bflo(pr.z); v[4] = x + (p - x) * m1.x;  x = bfhi(cu.z); p = bfhi(pr.z); v[5] = x + (p - x) * m1.y;
    x = bflo(cu.w); p = bflo(pr.w); v[6] = x + (p - x) * m1.z;  x = bfhi(cu.w); p = bfhi(pr.w); v[7] = x + (p - x) * m1.w;
}
__device__ __forceinline__ void rw_st_f32(LAS float* dst, const float (&v)[8]) { *(LAS f32x4*)dst = (f32x4){v[0], v[1], v[2], v[3]}; *(LAS f32x4*)(dst + 4) = (f32x4){v[4], v[5], v[6], v[7]}; }
__device__ __forceinline__ void rw_st_bf16(LAS bf16* dst, const float (&v)[8]) { u32x4 w; w.x = pk2(v[0], v[1]); w.y = pk2(v[2], v[3]); w.z = pk2(v[4], v[5]); w.w = pk2(v[6], v[7]); *(LAS u32x4*)dst = w; }
__device__ __forceinline__ void rwkv_head(LAS unsigned char* lds, const Args& a, const bf16* U, bf16* MIX, int b, int h, const int tid) {
    const int wave = __builtin_amdgcn_readfirstlane(tid >> 6), lane = tid & 63;
    LAS float* R = (LAS float*)(lds + 0 * RW_ARR); LAS float* Wd = (LAS float*)(lds + 1 * RW_ARR); LAS float* Kk = (LAS float*)(lds + 2 * RW_ARR); LAS float* Vv = (LAS float*)(lds + 3 * RW_ARR);
    LAS float* Aa = (LAS float*)(lds + 4 * RW_ARR); LAS float* Bb = (LAS float*)(lds + 5 * RW_ARR); LAS float* Gg = (LAS float*)(lds + 6 * RW_ARR); LAS float* Yy = (LAS float*)(lds + 7 * RW_ARR);
    LAS float* RK = (LAS float*)(lds + 8 * RW_ARR);
    LAS float* MU = (LAS float*)(lds + 8 * RW_ARR + 256);
    LAS bf16* XW = (LAS bf16*)(lds + 8 * RW_ARR + 256 + 2048); LAS bf16* XA = XW + 32 * RW_XWP; LAS bf16* XG = XA + 32 * RW_XWP;
    const int tok = tid >> 4, l16 = tid & 15, lo8 = (l16 < 8), l7 = l16 & 7;
    const int col0 = lo8 ? 64 * h + 8 * l7 : 512 + 64 * h + 8 * l7;
    const int col1 = lo8 ? 1024 + 64 * h + 8 * l7 : 1600 + 8 * l7;
    const int col2 = lo8 ? 1536 + 8 * l7 : 1664 + 8 * l7;
    const int col3 = 1728 + 8 * l16;
    __syncthreads();
    if (tid < 64) { const int i = tid >> 4, q = tid & 15; const bool q8 = q < 8; const int q7 = q & 7;
        const int cc = (i == 0) ? (q8 ? 64 * h + 8 * q7 : 512 + 64 * h + 8 * q7) : (i == 1) ? (q8 ? 1024 + 64 * h + 8 * q7 : 1600 + 8 * q7) : (i == 2) ? (q8 ? 1536 + 8 * q7 : 1664 + 8 * q7) : (q < 12 ? 1728 + 8 * q : 1728);
        const float* mu = a.in[I_MU] + cc;
#pragma unroll
        for (int e = 0; e < 8; ++e) MU[(i * 16 + q) * 8 + e] = mu[e]; }
    const int c4 = 4 * l16, gc = 64 * h + c4;
    const f32x4 kkw = *(const f32x4*)(a.in[I_KK] + gc), kaw = *(const f32x4*)(a.in[I_KA] + gc), rkw = *(const f32x4*)(a.in[I_RK] + gc);
    const f32x4 lg = *(const f32x4*)(a.in[I_LNG] + gc), lb = *(const f32x4*)(a.in[I_LNB] + gc);
    const int lkind = wave >> 1, lnt = wave & 1, lj = lane & 31, lhi = lane >> 5;
    const int lnks = (lkind == 2) ? 10 : 4;
    const int lgcol = 64 * h + 32 * lnt + lj;
    bf16x8 wf[10];
    float lbias = 0.f;
    if (wave < 6) {
        const bf16* wb = (lkind == 0 ? (const bf16*)(a.ws + WS_LW2) + (size_t)lgcol * 64 : lkind == 1 ? (const bf16*)(a.ws + WS_LA2) + (size_t)lgcol * 64 : (const bf16*)(a.ws + WS_LG2) + (size_t)lgcol * 160) + 8 * lhi;
#pragma unroll
        for (int ks = 0; ks < 10; ++ks) if (ks < lnks) wf[ks] = *(const bf16x8*)(wb + 16 * ks);
        if (lkind == 0) lbias = a.in[I_W0][lgcol]; else if (lkind == 1) lbias = a.in[I_A0][lgcol];
    }
    const int srow = 8 * wave + 2 * (lane >> 4), kl = lane & 15;
    f32x4 pvv = {0.f, 0.f, 0.f, 0.f}, pgg = {0.f, 0.f, 0.f, 0.f}; float prk = 0.f;
    float S00 = 0.f, S01 = 0.f, S02 = 0.f, S03 = 0.f, S10 = 0.f, S11 = 0.f, S12 = 0.f, S13 = 0.f;
    const bf16* ubase = U + ((size_t)b * SEQ + tok) * LDU + RW_OFF;
    u32x4 cu0, cu1, cu2, cu3, pr0, pr1, pr2, pr3;
    const u32x4 z4 = (u32x4){0u, 0u, 0u, 0u};
    cu0 = *(const u32x4*)(ubase + col0); cu1 = *(const u32x4*)(ubase + col1); cu2 = *(const u32x4*)(ubase + col2); cu3 = (l16 < 12) ? *(const u32x4*)(ubase + col3) : z4;
    pr0 = z4; pr1 = z4; pr2 = z4; pr3 = z4;
    if (tok > 0) { pr0 = *(const u32x4*)(ubase - LDU + col0); pr1 = *(const u32x4*)(ubase - LDU + col1); pr2 = *(const u32x4*)(ubase - LDU + col2); if (l16 < 12) pr3 = *(const u32x4*)(ubase - LDU + col3); }
    __syncthreads();
    for (int c = 0; c < SEQ / 32; ++c) {
        const int t0 = 32 * c;
        {
            float v[8];
            rw_lerp8(cu0, pr0, MU + (0 * 16 + l16) * 8, v); rw_st_f32((lo8 ? R : Kk) + tok * RW_P + 8 * l7, v);
            rw_lerp8(cu1, pr1, MU + (1 * 16 + l16) * 8, v);
            if (lo8) { LAS float* vp2 = Vv + (((tok >> 1) * 32 + 4 * l7) * 2 + (tok & 1)) * 2;
                       *(LAS f32x2*)vp2 = (f32x2){v[0], v[1]}; *(LAS f32x2*)(vp2 + 4) = (f32x2){v[2], v[3]}; *(LAS f32x2*)(vp2 + 8) = (f32x2){v[4], v[5]}; *(LAS f32x2*)(vp2 + 12) = (f32x2){v[6], v[7]}; }
            else rw_st_bf16(XA + tok * RW_XWP + 8 * l7, v);
            rw_lerp8(cu2, pr2, MU + (2 * 16 + l16) * 8, v);
            { const float s0 = lo8 ? -2.f : -1.f, s1 = lo8 ? 2.f : 1.f, s2 = lo8 ? -1.f : 0.f;
#pragma unroll
              for (int i = 0; i < 8; ++i) { const float xx = fminf(fmaxf(v[i], -30.f), 30.f); v[i] = fmaf(s1, __builtin_amdgcn_rcpf(1.f + __expf(s0 * xx)), s2); }
              rw_st_bf16((lo8 ? XW + tok * RW_XWP : XG + tok * RW_XGP) + 8 * l7, v); }
            if (l16 < 12) {
                rw_lerp8(cu3, pr3, MU + (3 * 16 + l16) * 8, v);
#pragma unroll
                for (int i = 0; i < 8; ++i) v[i] = __builtin_amdgcn_rcpf(1.f + __expf(-v[i]));
                rw_st_bf16(XG + tok * RW_XGP + 64 + 8 * l16, v); }
        }
        LDS_BARRIER();
        if (c + 1 < SEQ / 32) {
            const bf16* ub = ubase + (size_t)(t0 + 32) * LDU;
            cu0 = *(const u32x4*)(ub + col0); cu1 = *(const u32x4*)(ub + col1); cu2 = *(const u32x4*)(ub + col2); if (l16 < 12) cu3 = *(const u32x4*)(ub + col3);
            pr0 = *(const u32x4*)(ub - LDU + col0); pr1 = *(const u32x4*)(ub - LDU + col1); pr2 = *(const u32x4*)(ub - LDU + col2); if (l16 < 12) pr3 = *(const u32x4*)(ub - LDU + col3);
        }
        if (wave < 6) {
            const LAS bf16* xa = (lkind == 0 ? XW + lj * RW_XWP : lkind == 1 ? XA + lj * RW_XWP : XG + lj * RW_XGP) + 8 * lhi;
            f32x16 acc;
#pragma unroll
            for (int r = 0; r < 16; ++r) acc[r] = 0.f;
#pragma unroll
            for (int ks = 0; ks < 10; ++ks) if (ks < lnks) { const bf16x8 av = *(const LAS bf16x8*)(xa + 16 * ks); acc = MFMA32(av, wf[ks], acc); }
            const int col = 32 * lnt + lj;
            if (lkind == 0) {
#pragma unroll
                for (int r = 0; r < 16; ++r) { const int tk = 8 * (r >> 2) + 4 * lhi + (r & 3); const float x = lbias + acc[r];
                    const float w = -__logf(1.f + __expf(-x)) - 0.5f; Wd[tk * RW_P + col] = __expf(-__expf(w)); }
            } else if (lkind == 1) {
#pragma unroll
                for (int r = 0; r < 16; ++r) { const int tk = 8 * (r >> 2) + 4 * lhi + (r & 3); Bb[tk * RW_P + col] = __builtin_amdgcn_rcpf(1.f + __expf(-(lbias + acc[r]))); }
            } else {
#pragma unroll
                for (int r = 0; r < 16; ++r) { const int tk = 8 * (r >> 2) + 4 * lhi + (r & 3); Gg[tk * RW_P + col] = acc[r]; }
            }
        }
        LDS_BARRIER();
        {
            if (c > 0) {
                f32x4 y; { const LAS float* yq = (const LAS float*)(lds + 94208) + (tok * 32 + 2 * l16) * 8; const f32x4 v0 = *(const LAS f32x4*)yq, v1 = *(const LAS f32x4*)(yq + 4), v2 = *(const LAS f32x4*)(yq + 8), v3 = *(const LAS f32x4*)(yq + 12);
                  y = (f32x4){(v0.x + v0.z) + (v1.x + v1.z), (v0.y + v0.w) + (v1.y + v1.w), (v2.x + v2.z) + (v3.x + v3.z), (v2.y + v2.w) + (v3.y + v3.w)}; }
                const float mean = red16((y.x + y.y) + (y.z + y.w)) * (1.f / 64.f);
                const f32x4 d = y - mean;
                const float var = red16((d.x * d.x + d.y * d.y) + (d.z * d.z + d.w * d.w)) * (1.f / 64.f);
                const float rs = rsqrtf(var + LNX_EPS);
                const f32x4 o = (d * rs * lg + lb + prk * pvv) * pgg;
                u32x2 w; w.x = pk2(o.x, o.y); w.y = pk2(o.z, o.w);
                *(u32x2*)(MIX + ((size_t)b * SEQ + t0 - 32 + tok) * D_MODEL + 512 + gc) = w;
            }
            const f32x4 kr = *(LAS f32x4*)(Kk + tok * RW_P + c4), al = *(LAS f32x4*)(Bb + tok * RW_P + c4), rr = *(LAS f32x4*)(R + tok * RW_P + c4);
            { const LAS float* vp2 = Vv + (((tok >> 1) * 32 + 2 * l16) * 2 + (tok & 1)) * 2; const f32x2 va = *(const LAS f32x2*)vp2, vb = *(const LAS f32x2*)(vp2 + 4); pvv = (f32x4){va.x, va.y, vb.x, vb.y}; } pgg = *(LAS f32x4*)(Gg + tok * RW_P + c4);
            f32x4 kkv = kr * kkw;
            const float ssq = red16((kkv.x * kkv.x + kkv.y * kkv.y) + (kkv.z * kkv.z + kkv.w * kkv.w));
            const float inv = 1.f / fmaxf(sqrtf(ssq), 1e-12f);
            kkv = kkv * inv;
            const f32x4 km = kr * (1.f + (al - 1.f) * kaw);
            *(LAS f32x4*)(Aa + tok * RW_P + c4) = -kkv;
            *(LAS f32x4*)(Bb + tok * RW_P + c4) = kkv * al;
            *(LAS f32x4*)(Kk + tok * RW_P + c4) = km;
            const f32x4 pr = rr * km * rkw;
            prk = red16((pr.x + pr.y) + (pr.z + pr.w));
        }
        LDS_BARRIER();
        {
            const unsigned ak = (unsigned)(size_t)lds + 16u * kl, av = (unsigned)(size_t)lds + 3u * RW_ARR + 8u * srow;
            const unsigned yaddr = (unsigned)(size_t)(lds + 94208 + ((srow >> 1) * 4 + (kl >> 2)) * 8);
            const unsigned ystep = 1024u;
#define RW_LDS_STEP(tt) do { const unsigned _a = ak + (unsigned)((tt) * RW_P * 4); \
                asm volatile("ds_read_b128 %0, %1 offset:34816" : "=v"(na) : "v"(_a)); asm volatile("ds_read_b128 %0, %1 offset:8704" : "=v"(nw) : "v"(_a)); \
                asm volatile("ds_read_b128 %0, %1 offset:43520" : "=v"(nb) : "v"(_a)); asm volatile("ds_read_b128 %0, %1 offset:17408" : "=v"(nk) : "v"(_a)); \
                asm volatile("ds_read_b128 %0, %1" : "=v"(nr) : "v"(_a)); if (((tt) & 1) == 0) asm volatile("ds_read_b128 %0, %1" : "=v"(nv) : "v"(av + (unsigned)(((tt) >> 1) * 512))); } while (0)
            f32x4 na, nw, nb, nk, nr, nv;
            RW_LDS_STEP(0);
            asm volatile("s_waitcnt lgkmcnt(0)" : "+v"(na), "+v"(nw), "+v"(nb), "+v"(nk), "+v"(nr), "+v"(nv));
#pragma unroll 4
            for (int t = 0; t < 32; ++t) {
                const f32x4 a4 = na, w4 = nw, b4 = nb, k4 = nk, r4 = nr; const f32x2 v2 = (t & 1) ? (f32x2){nv.z, nv.w} : (f32x2){nv.x, nv.y};
                RW_LDS_STEP((t + 1) & 31);
                float sa0 = fmaf(S03, a4.w, fmaf(S02, a4.z, fmaf(S01, a4.y, S00 * a4.x)));
                float sa1 = fmaf(S13, a4.w, fmaf(S12, a4.z, fmaf(S11, a4.y, S10 * a4.x)));
                sa0 = red16(sa0); sa1 = red16(sa1);
                S00 = fmaf(v2.x, k4.x, fmaf(sa0, b4.x, S00 * w4.x)); S01 = fmaf(v2.x, k4.y, fmaf(sa0, b4.y, S01 * w4.y));
                S02 = fmaf(v2.x, k4.z, fmaf(sa0, b4.z, S02 * w4.z)); S03 = fmaf(v2.x, k4.w, fmaf(sa0, b4.w, S03 * w4.w));
                S10 = fmaf(v2.y, k4.x, fmaf(sa1, b4.x, S10 * w4.x)); S11 = fmaf(v2.y, k4.y, fmaf(sa1, b4.y, S11 * w4.y));
                S12 = fmaf(v2.y, k4.z, fmaf(sa1, b4.z, S12 * w4.z)); S13 = fmaf(v2.y, k4.w, fmaf(sa1, b4.w, S13 * w4.w));
                float y0 = fmaf(S03, r4.w, fmaf(S02, r4.z, fmaf(S01, r4.y, S00 * r4.x)));
                float y1 = fmaf(S13, r4.w, fmaf(S12, r4.z, fmaf(S11, r4.y, S10 * r4.x)));
                asm volatile("" : "+v"(y0), "+v"(y1));
                y0 += dppf<0xB1>(y0); y1 += dppf<0xB1>(y1); y0 += dppf<0x4E>(y0); y1 += dppf<0x4E>(y1);
                asm volatile("" : "+v"(y0), "+v"(y1));
                { const f32x2 yv = {y0, y1}; asm volatile("ds_write_b64 %0, %1" :: "v"(yaddr + (unsigned)(t * ystep)), "v"(yv)); }
                asm volatile("s_waitcnt lgkmcnt(0)" : "+v"(na), "+v"(nw), "+v"(nb), "+v"(nk), "+v"(nr), "+v"(nv));
            }
        }
        LDS_BARRIER();
    }
    {
        f32x4 y; { const LAS float* yq = (const LAS float*)(lds + 94208) + (tok * 32 + 2 * l16) * 8; const f32x4 v0 = *(const LAS f32x4*)yq, v1 = *(const LAS f32x4*)(yq + 4), v2 = *(const LAS f32x4*)(yq + 8), v3 = *(const LAS f32x4*)(yq + 12);
                  y = (f32x4){(v0.x + v0.z) + (v1.x + v1.z), (v0.y + v0.w) + (v1.y + v1.w), (v2.x + v2.z) + (v3.x + v3.z), (v2.y + v2.w) + (v3.y + v3.w)}; }
        const float mean = red16((y.x + y.y) + (y.z + y.w)) * (1.f / 64.f);
        const f32x4 d = y - mean;
        const float var = red16((d.x * d.x + d.y * d.y) + (d.z * d.z + d.w * d.w)) * (1.f / 64.f);
        const float rs = rsqrtf(var + LNX_EPS);
        const f32x4 o = (d * rs * lg + lb + prk * pvv) * pgg;
        u32x2 w; w.x = pk2(o.x, o.y); w.y = pk2(o.z, o.w);
        *(u32x2*)(MIX + ((size_t)b * SEQ + SEQ - 32 + tok) * D_MODEL + 512 + gc) = w;
    }
    __syncthreads();
}

#define XB_TMO      128
#define XB_XCNT(j)  (256  + 64 * (j))
#define XB_XSUB(j)  (1280 + 64 * (j))
#define XB_XGEN(j)  (2304 + 64 * (j))
#define XB_TOP      3328
#define XB_TOPGEN   3392
#define XCD_BAR_WORDS 3456
#define XB_SPIN_CAP (1u << 18)

__device__ __forceinline__ unsigned xb_ld(unsigned* p)              { return __hip_atomic_load(p, __ATOMIC_RELAXED, __HIP_MEMORY_SCOPE_AGENT); }
__device__ __forceinline__ unsigned xb_add(unsigned* p, unsigned v) { return __hip_atomic_fetch_add(p, v, __ATOMIC_RELAXED, __HIP_MEMORY_SCOPE_AGENT); }
__device__ __forceinline__ unsigned xb_xcc_id() { return (unsigned)__builtin_amdgcn_s_getreg((3 << 11) | 20) & 0xFu; }
#define XB_SPIN(cond, bar) do { unsigned _sp = 0; while (cond) { __builtin_amdgcn_s_sleep(1); \
    if ((++_sp & 255u) == 0u) { if (xb_ld(&(bar)[XB_TMO])) break; if (_sp > XB_SPIN_CAP) { atomicAdd(&(bar)[XB_TMO], 1u); break; } } } } while (0)

struct XcdBarrier {
    unsigned* bar; unsigned x;
    volatile LAS unsigned* st;
};

__device__ __forceinline__ XcdBarrier xcd_barrier_post(unsigned* bar, volatile LAS unsigned* st) {
    XcdBarrier b; b.bar = bar; b.x = xb_xcc_id(); b.st = st;
    if (threadIdx.x == 0) (void)xb_add(&bar[XB_XCNT(b.x)], 1u);
    return b;
}
__device__ __forceinline__ void xcd_barrier_complete(unsigned* bar, unsigned x, unsigned& nloc, unsigned& nx) {
    const unsigned G = gridDim.x * gridDim.y * gridDim.z;
    unsigned sum, cnt, mine, sp = 0u;
    for (;;) {
        sum = 0u; cnt = 0u; mine = 0u;
#pragma unroll
        for (unsigned j = 0; j < 16; ++j) { const unsigned c = xb_ld(&bar[XB_XCNT(j)]); sum += c; cnt += (c > 0u) ? 1u : 0u; mine = (j == x) ? c : mine; }
        if (sum == G) break;
        __builtin_amdgcn_s_sleep(1);
        if ((++sp & 255u) == 0u) { if (xb_ld(&bar[XB_TMO])) break; if (sp > XB_SPIN_CAP) { atomicAdd(&bar[XB_TMO], 1u); break; } }
    }
    nloc = mine > 0u ? mine : 1u; nx = cnt > 0u ? cnt : 1u;
}

__device__ __forceinline__ void xcd_barrier(const XcdBarrier& b) {
    asm volatile("s_waitcnt vmcnt(0)" ::: "memory");
    __syncthreads();
    if (threadIdx.x == 0) {
        unsigned* bar = b.bar;
        __builtin_amdgcn_s_waitcnt(0);
        unsigned nloc = b.st[0], nx = b.st[1];
        if (nloc == 0u) { xcd_barrier_complete(bar, b.x, nloc, nx); b.st[0] = nloc; b.st[1] = nx; }
        const unsigned old = xb_add(&bar[XB_XSUB(b.x)], 1u);
        const unsigned gen = old / nloc;
        if (old + 1u == (gen + 1u) * nloc) {
            __builtin_amdgcn_fence(__ATOMIC_RELEASE, "agent");
            asm volatile("s_waitcnt vmcnt(0)" ::: "memory");
            const unsigned og = xb_add(&bar[XB_TOP], 1u);
            const unsigned tg = og / nx;
            if (og + 1u == (tg + 1u) * nx) xb_add(&bar[XB_TOPGEN], 1u);
            else XB_SPIN(xb_ld(&bar[XB_TOPGEN]) == tg, bar);
            __builtin_amdgcn_fence(__ATOMIC_ACQUIRE, "agent");
            xb_add(&bar[XB_XGEN(b.x)], 1u);
            asm volatile("s_waitcnt vmcnt(0)" ::: "memory");
        } else {
            XB_SPIN(xb_ld(&bar[XB_XGEN(b.x)]) == gen, bar);
            __builtin_amdgcn_fence(__ATOMIC_ACQUIRE, "agent");
            asm volatile("s_waitcnt vmcnt(0)" ::: "memory");
        }
    }
    __syncthreads();
}

__device__ __forceinline__ void sub_barrier(unsigned* ctr, unsigned n) {
    asm volatile("s_waitcnt vmcnt(0)" ::: "memory");
    __syncthreads();
    if (threadIdx.x == 0) {
        __builtin_amdgcn_fence(__ATOMIC_RELEASE, "agent");
        asm volatile("s_waitcnt vmcnt(0)" ::: "memory");
        (void)__hip_atomic_fetch_add(ctr, 1u, __ATOMIC_RELAXED, __HIP_MEMORY_SCOPE_AGENT);
        unsigned sp = 0u;
        while (__hip_atomic_load(ctr, __ATOMIC_RELAXED, __HIP_MEMORY_SCOPE_AGENT) < n) { __builtin_amdgcn_s_sleep(2); if (++sp > (1u << 22)) break; }
        __builtin_amdgcn_fence(__ATOMIC_ACQUIRE, "agent");
        asm volatile("s_waitcnt vmcnt(0)" ::: "memory");
    }
    __syncthreads();
}
constexpr int MIXA_C0 = 1536;
constexpr int SUBBAR_WORD = 8192;
constexpr int N_PHASES = 16;
constexpr int XB_LDS_OFF = LDS_BYTES - 64, XB_WS_WORD = 4096;
__global__ void __launch_bounds__(NTHREADS, 2) mega_fwd(Args args) {
    extern __shared__ __attribute__((aligned(16))) unsigned char lds_raw[];
    LAS unsigned char* lds0 = (LAS unsigned char*)lds_raw;
    const Args* ap0 = (const Args*)__builtin_amdgcn_kernarg_segment_ptr();
    const int ph_lo = ap0->ph_lo, ph_hi = ap0->ph_hi;
    if (ph_hi - ph_lo > 1) {
        volatile LAS unsigned* bst = (volatile LAS unsigned*)(lds0 + XB_LDS_OFF);
        if (threadIdx.x < 2) bst[threadIdx.x] = 0u;
        __syncthreads();
        (void)xcd_barrier_post((unsigned*)(ap0->ws) + XB_WS_WORD, bst);
    }
    for (int ph = ph_lo; ph < ph_hi; ++ph) {
        const Args* ap = ap0; asm volatile("" : "+s"(ap));
        const Args& A = *ap;
        int tid = threadIdx.x; asm volatile("" : "+v"(tid));
        int G = gridDim.x, bid = blockIdx.x; asm volatile("" : "+s"(G), "+s"(bid));
        LAS unsigned char* lds = lds0; asm volatile("" : "+s"(lds));
        const int lane = tid & 63, wave = __builtin_amdgcn_readfirstlane(tid >> 6);
        const int gw = bid * NWAVES + wave, NGW = G * NWAVES;
        unsigned char* ws = A.ws;
        bool is_gemm = false; pg8::Gemm g{nullptr, nullptr, 0, 0, 0}; pg8::EpiU E{nullptr, 0, 0}; int gG = G, gc = bid;
        switch (ph) {
        case 0: prologue<0>(A, lds, gw, NGW, wave, lane); break;
        case 1: g = pg8::Gemm{(const bf16*)(ws + WS_XN), (const bf16*)(ws + WS_W1IN), M_TOK, 2 * D_FF, D_MODEL}; E = pg8::EpiU{(bf16*)(ws + WS_HU), D_FF, 1}; is_gemm = true; break;
        case 2: g = pg8::Gemm{(const bf16*)(ws + WS_HU), (const bf16*)(ws + WS_W1OUT), M_TOK, D_MODEL, D_FF}; E = pg8::EpiU{(bf16*)(ws + WS_Y), D_MODEL, 0}; is_gemm = true; break;
        case 3: norm_pass<false, true>((const bf16*)(ws + WS_Y), A.in[I_X], ws + WS_HB, 0.5f, A.in[I_F1POST], A.in[I_MIXPRE], (bf16*)(ws + WS_XN), gw, NGW, lane); break;
        case 4: g = pg8::Gemm{(const bf16*)(ws + WS_XN), (const bf16*)(ws + WS_WMIXIN) + (size_t)MIXA_C0 * D_MODEL, M_TOK, LDU - MIXA_C0, D_MODEL}; E = pg8::EpiU{(bf16*)(ws + WS_HU) + MIXA_C0, LDU, 0}; is_gemm = true; break;
        case 5: { const int nR = (G >= 256) ? 128 : (G / 2 > 0 ? G / 2 : 1);
                  if (bid >= nR) { g = pg8::Gemm{(const bf16*)(ws + WS_XN), (const bf16*)(ws + WS_WMIXIN), M_TOK, MIXA_C0, D_MODEL}; E = pg8::EpiU{(bf16*)(ws + WS_HU), LDU, 0}; is_gemm = true; gG = G - nR; gc = bid - nR; } } break;
        case 6: {
            const bf16* HU = (const bf16*)(ws + WS_HU); bf16* XN = (bf16*)(ws + WS_Y);
            const int nR = (G >= 256) ? 128 : (G / 2 > 0 ? G / 2 : 1);
            if (bid < nR) { for (int hd = bid; hd < BATCH * 8; hd += nR) rwkv_head(lds, A, HU, XN, hd >> 3, hd & 7, tid); }
            else { if (ph_hi - ph_lo > 1) sub_barrier((unsigned*)(ws) + SUBBAR_WORD, (unsigned)(G - nR));
                   for (int u = bid - nR; u < BATCH * 8 * 8; u += G - nR) { const int bh = u & 127, qb = 7 - (u >> 7); sb_unit(lds, HU, XN, A.in[I_SBG], bh >> 3, bh & 7, qb, tid); }
                   __syncthreads();
                   { const int sb = bid - nR, nsb = G - nR;
                     if (nsb == 128) { if (sb < 64) prologue<1>(A, lds, sb * NWAVES + wave, 2048, wave, lane);
                                       else { for (int k = 0; k < 3; ++k) { prologue<1>(A, lds, 512 + ((sb - 64) * NWAVES + wave) * 3 + k, 2048, wave, lane); } } }
                     else prologue<1>(A, lds, sb * NWAVES + wave, nsb * NWAVES, wave, lane); }
                   __syncthreads();
                   g = pg8::Gemm{(const bf16*)(ws + WS_MEMN), (const bf16*)(ws + WS_WKV), M_MEM, D_MODEL, D_MODEL}; E = pg8::EpiU{(bf16*)(ws + WS_KVM), D_MODEL, 0}; is_gemm = true; gG = G - nR; gc = bid - nR; }
        } break;
        case 7: g = pg8::Gemm{(const bf16*)(ws + WS_Y), (const bf16*)(ws + WS_WMIXOUT), M_TOK, D_MODEL, D_MODEL}; E = pg8::EpiU{(bf16*)(ws + WS_XN), D_MODEL, 0}; is_gemm = true; break;
        case 8: norm_pass<true, true>((const bf16*)(ws + WS_XN), ws + WS_HB, ws + WS_HB, 1.0f, A.in[I_MIXPOST], A.in[I_MEMPRE], (bf16*)(ws + WS_XN), gw, NGW, lane); break;
        case 9: g = pg8::Gemm{(const bf16*)(ws + WS_XN), (const bf16*)(ws + WS_WQ), M_TOK, MEM_W, D_MODEL}; E = pg8::EpiU{(bf16*)(ws + WS_QM), MEM_W, 0}; is_gemm = true; break;
        case 10: for (int pu = bid; pu < BATCH * 4 * 4; pu += G) { const int bm = pu >> 2, q0 = pu & 3, b = bm >> 2, mh = bm & 3;
                     __syncthreads(); xatt_stage(lds, (const bf16*)(ws + WS_KVM), b, mh, tid); __syncthreads();
                     xatt_unit(lds, (const bf16*)(ws + WS_QM), (bf16*)(ws + WS_OM), b, mh, q0, tid); xatt_unit(lds, (const bf16*)(ws + WS_QM), (bf16*)(ws + WS_OM), b, mh, q0 + 4, tid); } break;
        case 11: g = pg8::Gemm{(const bf16*)(ws + WS_OM), (const bf16*)(ws + WS_WO), M_TOK, D_MODEL, MEM_W}; E = pg8::EpiU{(bf16*)(ws + WS_Y), D_MODEL, 0}; is_gemm = true; break;
        case 12: norm_pass<true, true>((const bf16*)(ws + WS_Y), ws + WS_HB, ws + WS_HB, 1.0f, A.in[I_MEMPOST], A.in[I_F2PRE], (bf16*)(ws + WS_XN), gw, NGW, lane); break;
        case 13: g = pg8::Gemm{(const bf16*)(ws + WS_XN), (const bf16*)(ws + WS_W2IN), M_TOK, 2 * D_FF, D_MODEL}; E = pg8::EpiU{(bf16*)(ws + WS_HU), D_FF, 1}; is_gemm = true; break;
        case 14: g = pg8::Gemm{(const bf16*)(ws + WS_HU), (const bf16*)(ws + WS_W2OUT), M_TOK, D_MODEL, D_FF}; E = pg8::EpiU{(bf16*)(ws + WS_Y), D_MODEL, 0}; is_gemm = true; break;
        case 15: norm_pass<true, false>((const bf16*)(ws + WS_Y), ws + WS_HB, A.out, 0.5f, A.in[I_F2POST], nullptr, nullptr, gw, NGW, lane); break;
        default: break;
        }
        if (is_gemm) { pg8::StaticOrder S; S.init(g.M, g.N, gG, gc); pg8::gemm_phase<pg8::EpiU, pg8::StaticOrder, true, true>(lds, g, S, E, tid); }
        if (ph + 1 < ph_hi && ph != 5) {
            if (ph_hi > N_PHASES) { __syncthreads(); cg::this_grid().sync(); }
            else { XcdBarrier xb; xb.bar = (unsigned*)(A.ws) + XB_WS_WORD; xb.x = xb_xcc_id(); xb.st = (volatile LAS unsigned*)(lds + XB_LDS_OFF); xcd_barrier(xb); }
        }
    }
}

#ifndef MK_ONE_LAUNCH
#define MK_ONE_LAUNCH 1
#endif
extern "C" void kernel_launch(void* const* d_in, const int* in_sizes, int n_in, void* d_out, int out_size, void* d_ws, size_t ws_size, hipStream_t stream) {
    static int grid = 0;
    if (grid == 0) {
        if (n_in != N_IN || out_size != M_TOK * D_MODEL || ws_size < WS_END) { fprintf(stderr, "kernel_launch: unexpected shapes (n_in %d out %d ws %zu)\n", n_in, out_size, ws_size); grid = -1; return; }
        int dev = 0, cus = 0, per_cu = 0;
        if (hipGetDevice(&dev) != hipSuccess || hipDeviceGetAttribute(&cus, hipDeviceAttributeMultiprocessorCount, dev) != hipSuccess) { grid = -1; return; }
        if (hipFuncSetAttribute((const void*)mega_fwd, hipFuncAttributeMaxDynamicSharedMemorySize, LDS_BYTES) != hipSuccess) { fprintf(stderr, "kernel_launch: hipFuncSetAttribute failed\n"); grid = -1; return; }
        if (hipOccupancyMaxActiveBlocksPerMultiprocessor(&per_cu, (const void*)mega_fwd, NTHREADS, LDS_BYTES) != hipSuccess || per_cu < 1) { fprintf(stderr, "kernel_launch: occupancy query gave %d\n", per_cu); per_cu = 1; }
        (void)hipGetLastError();
        grid = cus;
    }
    if (grid < 0) return;
    if (hipMemsetAsync(d_ws, 0, 1u << 20, stream) != hipSuccess) { fprintf(stderr, "kernel_launch: memset of the control words failed\n"); return; }
    Args a{};
    for (int i = 0; i < N_IN; ++i) a.in[i] = (const float*)d_in[i];
    a.out = (float*)d_out; a.ws = (unsigned char*)d_ws;
#if MK_ONE_LAUNCH
    a.ph_lo = 0; a.ph_hi = N_PHASES;
    void* kargs[] = {&a};
    hipError_t e = hipLaunchCooperativeKernel((const void*)mega_fwd, dim3(grid), dim3(NTHREADS), kargs, LDS_BYTES, stream);
    if (e != hipSuccess) fprintf(stderr, "cooperative launch failed: %s (grid %d)\n", hipGetErrorString(e), grid);
#else
    for (int p = 0; p < N_PHASES; ++p) { a.ph_lo = p; a.ph_hi = p + 1; hipLaunchKernelGGL(mega_fwd, dim3(grid), dim3(NTHREADS), LDS_BYTES, stream, a); }
#endif
}
```

```cpp
#include <hip/hip_runtime.h>
#include <hip/hip_cooperative_groups.h>
#include <cstdio>
#include <cstdint>
namespace cg = cooperative_groups;
namespace pg8 {
#define PG8_LAS __attribute__((address_space(3)))
typedef unsigned short bf16_t;
typedef short bf16x8 __attribute__((ext_vector_type(8)));
typedef float f32x4 __attribute__((ext_vector_type(4)));
typedef unsigned u32x4 __attribute__((ext_vector_type(4)));
constexpr int BM = 256, BK = 64, HALF = 128, HTB = HALF * BK * 2  , STAGE_BYTES = 8 * HTB, NXCD = 8, WGM = 8;

__host__ __device__ __forceinline__ int lds_byte(int r, int c) { const int st = (r >> 4) * 2 + (c >> 5), rr = r & 15, cc = c & 31, ob = rr * 64 + cc * 2; return st * 1024 + (ob ^ (((ob >> 9) & 1) << 5)); }
__host__ __device__ __forceinline__ void stage_rc(int b, int& R, int& C) { const int st = b / 1024, sb = b % 1024, swz = sb ^ (((sb >> 9) & 1) << 5); R = (st >> 1) * 16 + swz / 64; C = (st & 1) * 32 + (swz % 64) / 2; }
__host__ __device__ __forceinline__ int perm32(int rho) { const int n = rho >> 4, i = rho & 15; return 8 * (i >> 2) + 4 * n + (i & 3); }

struct Unit { int pm, pn; };
struct Gemm { const bf16_t* A; const bf16_t* Bt; int M, N, K; };

struct StaticOrder {
    int nM, nN, nwg, G, c;
    __host__ __device__ void init(int M, int N, int G_, int c_) { nM = M / BM; nN = N / BM; nwg = nM * nN; G = G_; c = c_; }
    __host__ __device__ bool next(int i, Unit& u) const {
        const long L = (long)i * G + c; if (L >= nwg) return false;
        int wgid = (int)L; { const int q = nwg / NXCD, r = nwg % NXCD, xcd = wgid % NXCD, off = wgid / NXCD; wgid = (xcd < r ? xcd * (q + 1) : r * (q + 1) + (xcd - r) * q) + off; }
        const int nig = WGM * nN, gid = wgid / nig, fm = gid * WGM, gsz = (nM - fm) < WGM ? (nM - fm) : WGM;
        u.pm = fm + ((wgid % nig) % gsz); u.pn = (wgid % nig) / gsz; return true;
    }
    __device__ __forceinline__ void a_ready(const Unit&) const {}
    __device__ __forceinline__ void done(const Unit&) const {}
};
__device__ __forceinline__ unsigned cvt_pk_bf16(float lo, float hi) { unsigned r; asm volatile("v_cvt_pk_bf16_f32 %0, %1, %2" : "=v"(r) : "v"(lo), "v"(hi)); return r; }
typedef float f32x2 __attribute__((ext_vector_type(2)));
struct EpiU {
    static constexpr bool PERM = true, AFTER_DRAIN = false;
    bf16_t* O; int ldc; int mode;
    __device__ __forceinline__ void operator()(const f32x4 (&acc)[2][2][4][2], const Unit& u, int wr, int wc, int fr, int fq) const {
        const int row0 = u.pm * BM + wr * 64 + fr;
        if (mode == 0) {
            const int col0 = u.pn * BM + wc * 32 + 8 * fq;
#pragma unroll
            for (int ai = 0; ai < 2; ++ai)
#pragma unroll
                for (int m = 0; m < 4; ++m) { bf16_t* rowp = O + (size_t)(row0 + ai * HALF + m * 16) * ldc + col0;
#pragma unroll
                    for (int bj = 0; bj < 2; ++bj) { const f32x4 v0 = acc[ai][bj][m][0], v1 = acc[ai][bj][m][1];
                        u32x4 w; w.x = cvt_pk_bf16(v0[0], v0[1]); w.y = cvt_pk_bf16(v0[2], v0[3]); w.z = cvt_pk_bf16(v1[0], v1[1]); w.w = cvt_pk_bf16(v1[2], v1[3]);
                        *(u32x4*)(rowp + bj * HALF) = w; } }
        } else {
            const int col0 = u.pn * HALF + wc * 32 + 8 * fq;
#pragma unroll
            for (int ai = 0; ai < 2; ++ai)
#pragma unroll
                for (int m = 0; m < 4; ++m) { bf16_t* rowp = O + (size_t)(row0 + ai * HALF + m * 16) * ldc + col0;
                    float hv[8];
#pragma unroll
                    for (int n = 0; n < 2; ++n)
#pragma unroll
                        for (int j = 0; j < 4; ++j) { const float g = acc[ai][0][m][n][j], up = acc[ai][1][m][n][j];
                            hv[4 * n + j] = g * __builtin_amdgcn_rcpf(1.f + __expf(-g)) * up; }
                    u32x4 w; w.x = cvt_pk_bf16(hv[0], hv[1]); w.y = cvt_pk_bf16(hv[2], hv[3]); w.z = cvt_pk_bf16(hv[4], hv[5]); w.w = cvt_pk_bf16(hv[6], hv[7]);
                    *(u32x4*)rowp = w; }
        }
    }
};
template <class Epi, class Sched, bool ALIGN_EPI = false, bool SP2 = false>
__device__ __forceinline__ void gemm_phase(PG8_LAS unsigned char* lds, const Gemm g, const Sched& S, const Epi& E, const int tid) {
    const int wid = __builtin_amdgcn_readfirstlane(tid >> 6), lane = tid & 63, wr = wid >> 2, wc = wid & 3, fr = lane & 15, fq = lane >> 4;
    const int K = g.K, nt = K / BK;
    unsigned voffA[2], voffB[2];
#pragma unroll
    for (int i = 0; i < 2; ++i) { int R, C; stage_rc(tid * 16 + i * 8192, R, C); const int Rb = Epi::PERM ? ((R & ~31) + perm32(R & 31)) : R;
        voffA[i] = (unsigned)(R * K + C) * 2u; voffB[i] = (unsigned)(Rb * K + C) * 2u; }
    const size_t kstep = (size_t)(BK * 2);
    const size_t hstep = (size_t)HALF * K * 2;
    const size_t tstep = 2 * hstep;
    const unsigned ldsw = (unsigned)wid * 1024u;
    const int aoff = lds_byte(wr * 64 + fr, fq * 8), boff = lds_byte(wc * 32 + fr, fq * 8);
#define PG8_SA(b, h) (((b) * 2 + (h)) * HTB)
#define PG8_SB(b, h) ((4 + (b) * 2 + (h)) * HTB)
#define PG8_STAGE(bufoff, gbase, voff) do { _Pragma("unroll") for (int _i = 0; _i < 2; ++_i) \
        __builtin_amdgcn_global_load_lds((const unsigned*)((const char*)(gbase) + (voff)[_i]), (PG8_LAS unsigned*)(lds + (bufoff) + ldsw + _i * 8192), 16, 0, 0); } while (0)
#define PG8_LDA(dst, b, h) do { _Pragma("unroll") for (int m = 0; m < 4; ++m) _Pragma("unroll") for (int k = 0; k < 2; ++k) dst[m][k] = *(const PG8_LAS bf16x8*)(lds + PG8_SA(b, h) + aoff + m * 2048 + k * 1024); } while (0)
#define PG8_LDB(dst, b, h) do { _Pragma("unroll") for (int n = 0; n < 2; ++n) _Pragma("unroll") for (int k = 0; k < 2; ++k) dst[n][k] = *(const PG8_LAS bf16x8*)(lds + PG8_SB(b, h) + boff + n * 2048 + k * 1024); } while (0)
#define PG8_MMA(ai, bj, At, Bt) do { __builtin_amdgcn_s_setprio(1); _Pragma("unroll") for (int m = 0; m < 4; ++m) _Pragma("unroll") for (int n = 0; n < 2; ++n) _Pragma("unroll") for (int k = 0; k < 2; ++k) \
        acc[ai][bj][m][n] = __builtin_amdgcn_mfma_f32_16x16x32_bf16(Bt[n][k], At[m][k], acc[ai][bj][m][n], 0, 0, 0); __builtin_amdgcn_s_setprio(0); } while (0)
#define PG8_WAIT_V(n) asm volatile("s_waitcnt vmcnt(" #n ")" ::: "memory")
#define PG8_WAIT_L(n) asm volatile("s_waitcnt lgkmcnt(" #n ")" ::: "memory")
#define PG8_BAR __builtin_amdgcn_s_barrier()
#define PG8_SCHED __builtin_amdgcn_sched_barrier(0)
    Unit cur, nxt; int ui = 0;
    if (!S.next(0, cur)) return;
    f32x4 acc[2][2][4][2];
#pragma unroll
    for (int a = 0; a < 2; ++a)
#pragma unroll
        for (int b = 0; b < 2; ++b)
#pragma unroll
            for (int m = 0; m < 4; ++m)
#pragma unroll
                for (int n = 0; n < 2; ++n) acc[a][b][m][n] = (f32x4){0.f, 0.f, 0.f, 0.f};
    bf16x8 At[4][2], B0[2][2], B1[2][2];
    const char* cA = (const char*)g.A + (size_t)cur.pm * tstep; const char* cB = (const char*)g.Bt + (size_t)cur.pn * tstep;
    S.a_ready(cur);
    if constexpr (SP2) {
        PG8_STAGE(PG8_SB(0, 0), cB, voffB); PG8_STAGE(PG8_SB(0, 1), cB + hstep, voffB); PG8_STAGE(PG8_SA(0, 0), cA, voffA); PG8_STAGE(PG8_SA(0, 1), cA + hstep, voffA);
        if (wr == 1) PG8_BAR;
        PG8_WAIT_V(2); PG8_BAR;
        PG8_STAGE(PG8_SB(1, 0), cB + kstep, voffB); PG8_STAGE(PG8_SA(1, 0), cA + kstep, voffA); PG8_STAGE(PG8_SB(1, 1), cB + hstep + kstep, voffB);
        PG8_WAIT_V(6); PG8_BAR;
    } else {
        PG8_STAGE(PG8_SB(0, 0), cB, voffB); PG8_STAGE(PG8_SA(0, 0), cA, voffA); PG8_STAGE(PG8_SB(0, 1), cB + hstep, voffB); PG8_STAGE(PG8_SA(0, 1), cA + hstep, voffA);
        if (wr == 1) PG8_BAR;
        PG8_WAIT_V(4); PG8_BAR;
        PG8_STAGE(PG8_SB(1, 0), cB + kstep, voffB); PG8_STAGE(PG8_SA(1, 0), cA + kstep, voffA); PG8_STAGE(PG8_SB(1, 1), cB + hstep + kstep, voffB);
        PG8_WAIT_V(6); PG8_BAR;
    }
    for (;;) {
        const bool has_next = S.next(ui + 1, nxt);
        const char* nA = has_next ? (const char*)g.A + (size_t)nxt.pm * tstep : cA; const char* nB = has_next ? (const char*)g.Bt + (size_t)nxt.pn * tstep : cB;
        for (int t = 0; t < nt; t += 2) {
            const bool last = (t == nt - 2);
            const char* a1 = cA + (size_t)(t + 1) * kstep;
            const char* a2 = last ? nA : cA + (size_t)(t + 2) * kstep; const char* b2 = last ? nB : cB + (size_t)(t + 2) * kstep;
            const char* a3 = a2 + kstep; const char* b3 = b2 + kstep;
            if (last && has_next) S.a_ready(nxt);
            if constexpr (SP2) {
            PG8_LDB(B0, 0, 0); PG8_LDB(B1, 0, 1); PG8_SCHED; PG8_LDA(At, 0, 0); PG8_STAGE(PG8_SA(1, 1), a1 + hstep, voffA);
            PG8_WAIT_V(8); PG8_WAIT_L(0); PG8_BAR; PG8_MMA(0, 0, At, B0); PG8_MMA(0, 1, At, B1); PG8_BAR; PG8_SCHED;
            PG8_LDA(At, 0, 1); PG8_STAGE(PG8_SB(0, 0), b2, voffB); PG8_STAGE(PG8_SB(0, 1), b2 + hstep, voffB); PG8_STAGE(PG8_SA(0, 0), a2, voffA);
            PG8_WAIT_V(8); PG8_WAIT_L(0); PG8_BAR; PG8_MMA(1, 0, At, B0); PG8_MMA(1, 1, At, B1); PG8_BAR; PG8_SCHED;
            PG8_LDB(B0, 1, 0); PG8_LDB(B1, 1, 1); PG8_SCHED; PG8_LDA(At, 1, 0); PG8_STAGE(PG8_SA(0, 1), a2 + hstep, voffA);
            PG8_WAIT_V(8); PG8_WAIT_L(0); PG8_BAR; PG8_MMA(0, 0, At, B0); PG8_MMA(0, 1, At, B1); PG8_BAR; PG8_SCHED;
            PG8_LDA(At, 1, 1); PG8_STAGE(PG8_SB(1, 0), b3, voffB); PG8_STAGE(PG8_SB(1, 1), b3 + hstep, voffB); PG8_STAGE(PG8_SA(1, 0), a3, voffA);
            PG8_WAIT_V(8); PG8_WAIT_L(0); PG8_BAR; PG8_MMA(1, 0, At, B0); PG8_MMA(1, 1, At, B1); PG8_BAR; PG8_SCHED;
            } else {
            PG8_LDB(B0, 0, 0); PG8_SCHED; PG8_LDA(At, 0, 0); PG8_STAGE(PG8_SA(1, 1), a1 + hstep, voffA);
            PG8_WAIT_L(8); PG8_BAR; PG8_WAIT_L(0); PG8_MMA(0, 0, At, B0); PG8_BAR; PG8_SCHED;
            PG8_LDB(B1, 0, 1); PG8_STAGE(PG8_SB(0, 0), b2, voffB);
            PG8_BAR; PG8_WAIT_L(0); PG8_MMA(0, 1, At, B1); PG8_BAR;
            PG8_LDA(At, 0, 1); PG8_STAGE(PG8_SA(0, 0), a2, voffA);
            PG8_BAR; PG8_WAIT_L(0); PG8_MMA(1, 0, At, B0); PG8_BAR; PG8_SCHED;
            PG8_STAGE(PG8_SB(0, 1), b2 + hstep, voffB);
            PG8_WAIT_V(6); PG8_BAR; PG8_MMA(1, 1, At, B1); PG8_BAR;
            PG8_LDB(B0, 1, 0); PG8_SCHED; PG8_LDA(At, 1, 0); PG8_STAGE(PG8_SA(0, 1), a2 + hstep, voffA);
            PG8_WAIT_L(8); PG8_BAR; PG8_WAIT_L(0); PG8_MMA(0, 0, At, B0); PG8_BAR; PG8_SCHED;
            PG8_LDB(B1, 1, 1); PG8_STAGE(PG8_SB(1, 0), b3, voffB);
            PG8_BAR; PG8_WAIT_L(0); PG8_MMA(0, 1, At, B1); PG8_BAR;
            PG8_LDA(At, 1, 1); PG8_STAGE(PG8_SA(1, 0), a3, voffA);
            PG8_BAR; PG8_WAIT_L(0); PG8_MMA(1, 0, At, B0); PG8_BAR; PG8_SCHED;
            PG8_STAGE(PG8_SB(1, 1), b3 + hstep, voffB);
            PG8_WAIT_V(6); PG8_BAR; PG8_MMA(1, 1, At, B1); PG8_BAR;
            }
        }
        if constexpr (ALIGN_EPI) { if (wr == 0) PG8_BAR; }
        if constexpr (!Epi::AFTER_DRAIN) { E(acc, cur, wr, wc, fr, fq); S.done(cur); }
        if (!has_next) break;
#pragma unroll
        for (int a = 0; a < 2; ++a)
#pragma unroll
            for (int b = 0; b < 2; ++b)
#pragma unroll
                for (int m = 0; m < 4; ++m)
#pragma unroll
                    for (int n = 0; n < 2; ++n) acc[a][b][m][n] = (f32x4){0.f, 0.f, 0.f, 0.f};
        cur = nxt; cA = nA; cB = nB; ++ui;
        if constexpr (ALIGN_EPI) { if (wr == 1) PG8_BAR; }
    }
    PG8_WAIT_V(0);
    if constexpr (!ALIGN_EPI) { if (wr == 0) PG8_BAR; }
    PG8_BAR;
    if constexpr (Epi::AFTER_DRAIN) { E.fused(acc, cur, wr, wc, fr, fq, lds, wid, lane); S.done(cur); }
#undef PG8_SA
#undef PG8_SB
#undef PG8_STAGE
#undef PG8_LDA
#undef PG8_LDB
#undef PG8_MMA
#undef PG8_WAIT_V
#undef PG8_WAIT_L
#undef PG8_BAR
#undef PG8_SCHED
}
}

constexpr int D_MODEL = 1024, BATCH = 16, SEQ = 2048, M_TOK = BATCH * SEQ;
constexpr int MEM_LEN = 256, M_MEM = BATCH * MEM_LEN;
constexpr int D_FF = 2816, MIX_IN = 3360, LDU = 3584, RW_OFF = 1536, RWKV_IN = 1824;
constexpr int MEM_W = 512;
constexpr float NORM_EPS = 1e-6f, LNX_EPS = 64e-5f;
constexpr int NWAVES = 8, NTHREADS = 512;
constexpr int LDS_BYTES = 147456;
enum { I_X = 0, I_MEM, I_F1PRE, I_F1POST, I_F1WIN, I_F1WOUT, I_MIXPRE, I_MIXPOST, I_MIXWIN, I_MU, I_W0, I_W2, I_A0, I_A2, I_G2, I_KK, I_KA, I_RK, I_LNG, I_LNB,
       I_SBG, I_MIXWOUT, I_MEMPRE, I_MEMPOST, I_MEMKVG, I_WQ, I_WKV, I_WO, I_F2PRE, I_F2POST, I_F2WIN, I_F2WOUT, N_IN };
constexpr size_t MiB = 1u << 20;
constexpr size_t WS_W1IN = 2 * MiB, WS_W1OUT = 13 * MiB, WS_WMIXIN = 19 * MiB, WS_WMIXOUT = 26 * MiB, WS_WQ = 28 * MiB, WS_WKV = 29 * MiB, WS_WO = 31 * MiB,
                 WS_W2IN = 32 * MiB, WS_W2OUT = 43 * MiB, WS_LW2 = 49 * MiB, WS_LA2 = WS_LW2 + 65536, WS_LG2 = WS_LA2 + 65536,
                 WS_MEMN = 56 * MiB, WS_KVM = 64 * MiB, WS_XN = 72 * MiB, WS_Y = 136 * MiB, WS_HU = 200 * MiB, WS_HB = 424 * MiB, WS_END = 488 * MiB;
constexpr size_t WS_QM = WS_HU, WS_OM = WS_HU + 32 * MiB;

#define LAS __attribute__((address_space(3)))
typedef unsigned short bf16;
typedef short bf16x8 __attribute__((ext_vector_type(8)));
typedef short s16x4 __attribute__((ext_vector_type(4)));
typedef float f32x4 __attribute__((ext_vector_type(4)));
typedef float f32x2 __attribute__((ext_vector_type(2)));
typedef float f32x16 __attribute__((ext_vector_type(16)));
typedef unsigned u32x4 __attribute__((ext_vector_type(4)));
typedef unsigned u32x2 __attribute__((ext_vector_type(2)));

__device__ __forceinline__ float bflo(unsigned u) { return __uint_as_float(u << 16); }
__device__ __forceinline__ float bfhi(unsigned u) { return __uint_as_float(u & 0xffff0000u); }
__device__ __forceinline__ unsigned pk2(float lo, float hi) { return pg8::cvt_pk_bf16(lo, hi); }
template <int CTRL> __device__ __forceinline__ float dppf(float x) { return __builtin_bit_cast(float, __builtin_amdgcn_mov_dpp(__builtin_bit_cast(int, x), CTRL, 0xf, 0xf, true)); }
__device__ __forceinline__ float red16(float x) { x += dppf<0xB1>(x); x += dppf<0x4E>(x); x += dppf<0x141>(x); x += dppf<0x140>(x); return x; }
__device__ __forceinline__ float half_sum(float x) { auto t = __builtin_amdgcn_permlane32_swap(__float_as_uint(x), __float_as_uint(x), false, false); return __uint_as_float(t[0]) + __uint_as_float(t[1]); }
__device__ __forceinline__ float half_max(float x) { auto t = __builtin_amdgcn_permlane32_swap(__float_as_uint(x), __float_as_uint(x), false, false); return fmaxf(__uint_as_float(t[0]), __uint_as_float(t[1])); }
__device__ __forceinline__ float half_other(float x, int hi) { auto t = __builtin_amdgcn_permlane32_swap(__float_as_uint(x), __float_as_uint(x), false, false); return hi ? __uint_as_float(t[0]) : __uint_as_float(t[1]); }
__device__ __forceinline__ float wave_sum(float v) {
    v = red16(v);
    auto s = __builtin_amdgcn_permlane16_swap(__float_as_uint(v), __float_as_uint(v), false, false);
    v = __uint_as_float(s[0]) + __uint_as_float(s[1]);
    return half_sum(v);
}
#define LDS_BARRIER() do { asm volatile("s_waitcnt lgkmcnt(0)" ::: "memory"); __builtin_amdgcn_s_barrier(); asm volatile("" ::: "memory"); } while (0)
#define MFMA32(a, b, c) __builtin_amdgcn_mfma_f32_32x32x16_bf16((a), (b), (c), 0, 0, 0)

struct Args { const float* in[N_IN]; float* out; unsigned char* ws; int ph_lo, ph_hi; };

__device__ __forceinline__ void transpose_item(const float* W, int K, int N, bf16* WT, int ldk, int k0, int n0, int drow0, LAS float* scr, int lane) {
    float tv[32];
#pragma unroll
    for (int i = 0; i < 32; ++i) { const int k = k0 + 2 * i + (lane >> 5); tv[i] = (k < K) ? W[(size_t)k * N + n0 + (lane & 31)] : 0.f; }
#pragma unroll
    for (int i = 0; i < 32; ++i) scr[(2 * i + (lane >> 5)) * 33 + (lane & 31)] = tv[i];
    asm volatile("s_waitcnt lgkmcnt(0)" ::: "memory");
    const int c = lane & 7;
#pragma unroll
    for (int j = 0; j < 4; ++j) { const int n = (lane >> 3) + 8 * j; const LAS float* s = scr + (8 * c) * 33 + n;
        u32x4 o; o.x = pk2(s[0 * 33], s[1 * 33]); o.y = pk2(s[2 * 33], s[3 * 33]); o.z = pk2(s[4 * 33], s[5 * 33]); o.w = pk2(s[6 * 33], s[7 * 33]);
        if (k0 + 8 * c + 8 <= ldk) *(u32x4*)(WT + (size_t)(drow0 + n) * ldk + k0 + 8 * c) = o; }
    asm volatile("s_waitcnt lgkmcnt(0)" ::: "memory");
}
__device__ __forceinline__ void transpose_matrix_item(const float* W, int K, int N, bf16* WT, int ldk, int mode, int item, LAS float* scr, int lane) {
    const int nblk = N / 32, kb = item / nblk, nb = item % nblk, n0 = 32 * nb;
    int drow0 = n0;
    if (mode == 1) { drow0 = (n0 < D_FF) ? (n0 / 128) * 256 + (n0 % 128) : ((n0 - D_FF) / 128) * 256 + 128 + ((n0 - D_FF) % 128); }
    transpose_item(W, K, N, WT, ldk, 64 * kb, n0, drow0, scr, lane);
}
__device__ __forceinline__ void rms_rows2_to_bf16(const float* xrow, const float* g, bf16* orow, int lane) {
    const f32x4* gr = (const f32x4*)g + lane;
    f32x4 v[2][4]; float s[2] = {0.f, 0.f};
#pragma unroll
    for (int q = 0; q < 2; ++q) { const f32x4* xr = (const f32x4*)(xrow + (size_t)q * D_MODEL) + lane;
#pragma unroll
        for (int j = 0; j < 4; ++j) v[q][j] = xr[64 * j]; }
#pragma unroll
    for (int q = 0; q < 2; ++q)
#pragma unroll
        for (int j = 0; j < 4; ++j) s[q] += (v[q][j].x * v[q][j].x + v[q][j].y * v[q][j].y) + (v[q][j].z * v[q][j].z + v[q][j].w * v[q][j].w);
#pragma unroll
    for (int q = 0; q < 2; ++q) {
        const float rs = rsqrtf(wave_sum(s[q]) * (1.f / D_MODEL) + NORM_EPS);
        u32x2* o8 = (u32x2*)(orow + (size_t)q * D_MODEL) + lane;
#pragma unroll
        for (int j = 0; j < 4; ++j) { const f32x4 gg = gr[64 * j]; u32x2 o; o.x = pk2(v[q][j].x * rs * gg.x, v[q][j].y * rs * gg.y); o.y = pk2(v[q][j].z * rs * gg.z, v[q][j].w * rs * gg.w); o8[64 * j] = o; }
    }
}
template <int PART>
__device__ __forceinline__ void prologue(const Args& a, LAS unsigned char* lds, int gw, int NGW, int wave, int lane) {
    LAS float* scr = (LAS float*)(lds + wave * 16384);
    unsigned char* ws = a.ws;
    constexpr int I_FIN = (D_MODEL / 64) * (2 * D_FF / 32), I_FOUT = (D_FF / 64) * (D_MODEL / 32), I_MIN = (D_MODEL / 64) * (MIX_IN / 32), I_SQ = (D_MODEL / 64) * (D_MODEL / 32),
                  I_Q = (D_MODEL / 64) * (MEM_W / 32), I_O = (MEM_W / 64) * (D_MODEL / 32), I_L64 = 16, I_L160 = 48;
    if (PART == 0) {
        constexpr int NITEMS = I_FIN + I_FOUT + I_MIN + I_SQ + 2 * I_L64 + I_L160;
        for (int it = gw; it < NITEMS; it += NGW) {
            int r = it;
            if (r < I_FIN) { transpose_matrix_item(a.in[I_F1WIN], D_MODEL, 2 * D_FF, (bf16*)(ws + WS_W1IN), D_MODEL, 1, r, scr, lane); continue; } r -= I_FIN;
            if (r < I_FOUT) { transpose_matrix_item(a.in[I_F1WOUT], D_FF, D_MODEL, (bf16*)(ws + WS_W1OUT), D_FF, 0, r, scr, lane); continue; } r -= I_FOUT;
            if (r < I_MIN) { transpose_matrix_item(a.in[I_MIXWIN], D_MODEL, MIX_IN, (bf16*)(ws + WS_WMIXIN), D_MODEL, 0, r, scr, lane); continue; } r -= I_MIN;
            if (r < I_SQ) { transpose_matrix_item(a.in[I_WKV], D_MODEL, D_MODEL, (bf16*)(ws + WS_WKV), D_MODEL, 0, r, scr, lane); continue; } r -= I_SQ;
            if (r < I_L64) { transpose_matrix_item(a.in[I_W2], 64, 512, (bf16*)(ws + WS_LW2), 64, 0, r, scr, lane); continue; } r -= I_L64;
            if (r < I_L64) { transpose_matrix_item(a.in[I_A2], 64, 512, (bf16*)(ws + WS_LA2), 64, 0, r, scr, lane); continue; } r -= I_L64;
            transpose_matrix_item(a.in[I_G2], 160, 512, (bf16*)(ws + WS_LG2), 160, 0, r, scr, lane);
        }
        { u32x4* z = (u32x4*)((bf16*)(ws + WS_WMIXIN) + (size_t)MIX_IN * D_MODEL); const int n16 = (LDU - MIX_IN) * D_MODEL * 2 / 16;
          for (int i = gw * 64 + lane; i < n16; i += NGW * 64) z[i] = (u32x4){0u, 0u, 0u, 0u}; }
        for (int m = 2 * gw; m < M_TOK; m += 2 * NGW) rms_rows2_to_bf16(a.in[I_X] + (size_t)m * D_MODEL, a.in[I_F1PRE], (bf16*)(ws + WS_XN) + (size_t)m * D_MODEL, lane);
        for (int m = 2 * gw; m < M_MEM; m += 2 * NGW) rms_rows2_to_bf16(a.in[I_MEM] + (size_t)m * D_MODEL, a.in[I_MEMKVG], (bf16*)(ws + WS_MEMN) + (size_t)m * D_MODEL, lane);
    } else {
        constexpr int NITEMS = I_FIN + I_FOUT + I_SQ + I_Q + I_O;
        for (int it = gw; it < NITEMS; it += NGW) {
            int r = it;
            if (r < I_SQ) { transpose_matrix_item(a.in[I_MIXWOUT], D_MODEL, D_MODEL, (bf16*)(ws + WS_WMIXOUT), D_MODEL, 0, r, scr, lane); continue; } r -= I_SQ;
            if (r < I_Q) { transpose_matrix_item(a.in[I_WQ], D_MODEL, MEM_W, (bf16*)(ws + WS_WQ), D_MODEL, 0, r, scr, lane); continue; } r -= I_Q;
            if (r < I_O) { transpose_matrix_item(a.in[I_WO], MEM_W, D_MODEL, (bf16*)(ws + WS_WO), MEM_W, 0, r, scr, lane); continue; } r -= I_O;
            if (r < I_FIN) { transpose_matrix_item(a.in[I_F2WIN], D_MODEL, 2 * D_FF, (bf16*)(ws + WS_W2IN), D_MODEL, 1, r, scr, lane); continue; } r -= I_FIN;
            transpose_matrix_item(a.in[I_F2WOUT], D_FF, D_MODEL, (bf16*)(ws + WS_W2OUT), D_FF, 0, r, scr, lane);
        }
    }
}
template <bool HIN_BF, bool HOUT_BF>
__device__ __forceinline__ void norm_pass(const bf16* Y, const void* hin_, void* hout_, float coef, const float* gpost, const float* gpre, bf16* XN, int gw, int NGW, int lane) {
    f32x4 gp[4], gq[4];
#pragma unroll
    for (int j = 0; j < 4; ++j) { gp[j] = ((const f32x4*)gpost + lane)[64 * j]; gq[j] = gpre ? ((const f32x4*)gpre + lane)[64 * j] : (f32x4){0.f, 0.f, 0.f, 0.f}; }
    u32x2 ry[2][4]; u32x2 rhb[2][4]; f32x4 rhf[2][4];
#define NP_LOAD(r0) do { _Pragma("unroll") for (int q = 0; q < 2; ++q) { \
        const u32x2* yr = (const u32x2*)(Y + (size_t)((r0) + q) * D_MODEL) + lane; \
        _Pragma("unroll") for (int j = 0; j < 4; ++j) ry[q][j] = yr[64 * j]; \
        if (HIN_BF) { const u32x2* hr = (const u32x2*)((const bf16*)hin_ + (size_t)((r0) + q) * D_MODEL) + lane; _Pragma("unroll") for (int j = 0; j < 4; ++j) rhb[q][j] = hr[64 * j]; } \
        else { const f32x4* hr = (const f32x4*)((const float*)hin_ + (size_t)((r0) + q) * D_MODEL) + lane; _Pragma("unroll") for (int j = 0; j < 4; ++j) rhf[q][j] = hr[64 * j]; } } } while (0)
    int row0 = 2 * gw;
    if (row0 < M_TOK) NP_LOAD(row0);
    for (; row0 < M_TOK; row0 += 2 * NGW) {
        f32x4 y[2][4], h[2][4]; float s[2] = {0.f, 0.f};
#pragma unroll
        for (int q = 0; q < 2; ++q)
#pragma unroll
            for (int j = 0; j < 4; ++j) { const u32x2 t = ry[q][j]; y[q][j] = (f32x4){bflo(t.x), bfhi(t.x), bflo(t.y), bfhi(t.y)};
                if (HIN_BF) { const u32x2 u = rhb[q][j]; h[q][j] = (f32x4){bflo(u.x), bfhi(u.x), bflo(u.y), bfhi(u.y)}; } else h[q][j] = rhf[q][j]; }
        if (row0 + 2 * NGW < M_TOK) NP_LOAD(row0 + 2 * NGW);
#pragma unroll
        for (int q = 0; q < 2; ++q)
#pragma unroll
            for (int j = 0; j < 4; ++j) s[q] += (y[q][j].x * y[q][j].x + y[q][j].y * y[q][j].y) + (y[q][j].z * y[q][j].z + y[q][j].w * y[q][j].w);
#pragma unroll
        for (int q = 0; q < 2; ++q) {
            const float rs = rsqrtf(wave_sum(s[q]) * (1.f / D_MODEL) + NORM_EPS) * coef;
            float s2 = 0.f;
#pragma unroll
            for (int j = 0; j < 4; ++j) { h[q][j] = h[q][j] + y[q][j] * rs * gp[j];
                s2 += (h[q][j].x * h[q][j].x + h[q][j].y * h[q][j].y) + (h[q][j].z * h[q][j].z + h[q][j].w * h[q][j].w); }
            if (HOUT_BF) { u32x2* orow = (u32x2*)((bf16*)hout_ + (size_t)(row0 + q) * D_MODEL) + lane;
#pragma unroll
                for (int j = 0; j < 4; ++j) { u32x2 o; o.x = pk2(h[q][j].x, h[q][j].y); o.y = pk2(h[q][j].z, h[q][j].w); orow[64 * j] = o; } }
            else { f32x4* orow = (f32x4*)((float*)hout_ + (size_t)(row0 + q) * D_MODEL) + lane;
#pragma unroll
                for (int j = 0; j < 4; ++j) orow[64 * j] = h[q][j]; }
            if (gpre) {
                const float rs2 = rsqrtf(wave_sum(s2) * (1.f / D_MODEL) + NORM_EPS);
                u32x2* o8 = (u32x2*)(XN + (size_t)(row0 + q) * D_MODEL) + lane;
#pragma unroll
                for (int j = 0; j < 4; ++j) { const f32x4 g = gq[j]; u32x2 o; o.x = pk2(h[q][j].x * rs2 * g.x, h[q][j].y * rs2 * g.y); o.y = pk2(h[q][j].z * rs2 * g.z, h[q][j].w * rs2 * g.w); o8[64 * j] = o; }
            }
        }
    }
#undef NP_LOAD
}
constexpr int SB_KP = 72, SB_VP = 72;
typedef short v4i16_t __attribute__((ext_vector_type(4)));
__device__ __forceinline__ s16x4 lds_tr16(const LAS bf16* p) { return __builtin_bit_cast(s16x4, __builtin_amdgcn_ds_read_tr16_b64_v4i16((LAS v4i16_t*)p)); }
__device__ __forceinline__ void sb_unit(LAS unsigned char* lds, const bf16* U, bf16* MIX, const float* sbg, int b, int h, int qb, const int tid) {
    const int wave = tid >> 6, lane = tid & 63, j = lane & 31, hi = lane >> 5;
    LAS bf16* Ks = (LAS bf16*)lds;
    LAS bf16* Vt = (LAS bf16*)(lds + 64 * SB_KP * 2);
    const int qw = 256 * qb + 32 * wave;
    const size_t rowbase = (size_t)b * SEQ;
    bf16x8 qf[4];
    { const bf16* qp = U + (rowbase + qw + j) * LDU + h * 64 + 8 * hi;
#pragma unroll
      for (int ks = 0; ks < 4; ++ks) { const u32x4 raw = *(const u32x4*)(qp + 16 * ks); u32x4 sc;
          const float qs = 0.125f * 1.4426950408889634f;
          sc.x = pk2(bflo(raw.x) * qs, bfhi(raw.x) * qs); sc.y = pk2(bflo(raw.y) * qs, bfhi(raw.y) * qs);
          sc.z = pk2(bflo(raw.z) * qs, bfhi(raw.z) * qs); sc.w = pk2(bflo(raw.w) * qs, bfhi(raw.w) * qs);
          qf[ks] = __builtin_bit_cast(bf16x8, sc); } }
    f32x16 o0, o1;
#pragma unroll
    for (int r = 0; r < 16; ++r) { o0[r] = 0.f; o1[r] = 0.f; }
    float carry = 1.f;
    const int st_key = tid >> 3, st_dg = tid & 7;
    const bf16* kp0 = U + (rowbase + st_key) * LDU + 512 + h * 64 + 8 * st_dg;
    u32x4 kv = *(const u32x4*)(kp0 + (size_t)(64 * (4 * qb + 3)) * LDU), vv = *(const u32x4*)(kp0 + (size_t)(64 * (4 * qb + 3)) * LDU + 512);
    for (int jt = 4 * qb + 3; jt >= 0; --jt) {
        LDS_BARRIER();
        { *(LAS u32x4*)(Ks + st_key * SB_KP + 8 * st_dg) = kv;
          *(LAS u32x4*)(Vt + st_key * SB_VP + 8 * st_dg) = vv; }
        LDS_BARRIER();
        if (jt > 0) { kv = *(const u32x4*)(kp0 + (size_t)(64 * (jt - 1)) * LDU); vv = *(const u32x4*)(kp0 + (size_t)(64 * (jt - 1)) * LDU + 512); }
#pragma unroll 1
        for (int sub = 1; sub >= 0; --sub) {
            const int kbase = 64 * jt + 32 * sub;
            if (kbase > qw) continue;
            f32x16 acc;
#pragma unroll
            for (int r = 0; r < 16; ++r) acc[r] = 0.f;
#pragma unroll
            for (int ks = 0; ks < 4; ++ks) { const bf16x8 a = *(const LAS bf16x8*)(Ks + (32 * sub + j) * SB_KP + 16 * ks + 8 * hi); acc = MFMA32(a, qf[ks], acc); }
            const bool diag = (kbase == qw);
            float e[16], incl[16];
#pragma unroll
            for (int r = 0; r < 16; ++r) { const int i = 8 * (r >> 2) + 4 * hi + (r & 3); const float z = fminf(acc[r], 115.f);
                float ev = __builtin_amdgcn_exp2f(z); float dv = __builtin_amdgcn_rcpf(1.f + ev);
                if (diag && i >= j) { ev = 0.f; dv = 1.f; }
                e[r] = ev; incl[r] = dv; }
            float GP[4], GPo[4];
#pragma unroll
            for (int g = 0; g < 4; ++g) { incl[4 * g + 2] *= incl[4 * g + 3]; incl[4 * g + 1] *= incl[4 * g + 2]; incl[4 * g] *= incl[4 * g + 1]; GP[g] = incl[4 * g]; GPo[g] = half_other(GP[g], hi); }
            float ma[4], oi[4], base[4];
            ma[3] = 1.f; ma[2] = GP[3]; ma[1] = GP[2] * ma[2]; ma[0] = GP[1] * ma[1];
            oi[3] = GPo[3]; oi[2] = GPo[2] * oi[3]; oi[1] = GPo[1] * oi[2]; oi[0] = GPo[0] * oi[1];
            base[0] = carry * ma[0] * (hi ? oi[1] : oi[0]); base[1] = carry * ma[1] * (hi ? oi[2] : oi[1]);
            base[2] = carry * ma[2] * (hi ? oi[3] : oi[2]); base[3] = carry * ma[3] * (hi ? 1.f : oi[3]);
            carry = carry * ((GP[0] * ma[0]) * oi[0]);
            u32x4 p0, p1;
            p0.x = pk2(e[0] * incl[0] * base[0], e[1] * incl[1] * base[0]); p0.y = pk2(e[2] * incl[2] * base[0], e[3] * incl[3] * base[0]);
            p0.z = pk2(e[4] * incl[4] * base[1], e[5] * incl[5] * base[1]); p0.w = pk2(e[6] * incl[6] * base[1], e[7] * incl[7] * base[1]);
            p1.x = pk2(e[8] * incl[8] * base[2], e[9] * incl[9] * base[2]); p1.y = pk2(e[10] * incl[10] * base[2], e[11] * incl[11] * base[2]);
            p1.z = pk2(e[12] * incl[12] * base[3], e[13] * incl[13] * base[3]); p1.w = pk2(e[14] * incl[14] * base[3], e[15] * incl[15] * base[3]);
            const bf16x8 pa0 = __builtin_bit_cast(bf16x8, p0), pa1 = __builtin_bit_cast(bf16x8, p1);
#pragma unroll
            for (int s = 0; s < 2; ++s) {
                const bf16x8 pb = s ? pa1 : pa0;
                const LAS bf16* vp = Vt + (32 * sub + 16 * s + 4 * hi + ((lane & 15) >> 2)) * SB_VP + 16 * ((lane >> 4) & 1) + 4 * (lane & 3);
                { const s16x4 lo = lds_tr16(vp), hh = lds_tr16(vp + 8 * SB_VP); const bf16x8 va = __builtin_shufflevector(lo, hh, 0, 1, 2, 3, 4, 5, 6, 7); o0 = MFMA32(va, pb, o0); }
                { const s16x4 lo = lds_tr16(vp + 32), hh = lds_tr16(vp + 8 * SB_VP + 32); const bf16x8 va = __builtin_shufflevector(lo, hh, 0, 1, 2, 3, 4, 5, 6, 7); o1 = MFMA32(va, pb, o1); }
            }
        }
    }
    float ss = 0.f;
#pragma unroll
    for (int r = 0; r < 16; ++r) ss += o0[r] * o0[r] + o1[r] * o1[r];
    ss = half_sum(ss);
    const float rs = rsqrtf(ss * (1.f / 64.f) + NORM_EPS);
    bf16* op = MIX + (rowbase + qw + j) * D_MODEL + h * 64 + 4 * hi;
    const float* gp = sbg + h * 64 + 4 * hi;
#pragma unroll
    for (int g = 0; g < 4; ++g) {
        const f32x4 g0 = *(const f32x4*)(gp + 8 * g), g1 = *(const f32x4*)(gp + 32 + 8 * g);
        u32x2 w0, w1;
        w0.x = pk2(o0[4 * g] * rs * g0.x, o0[4 * g + 1] * rs * g0.y); w0.y = pk2(o0[4 * g + 2] * rs * g0.z, o0[4 * g + 3] * rs * g0.w);
        w1.x = pk2(o1[4 * g] * rs * g1.x, o1[4 * g + 1] * rs * g1.y); w1.y = pk2(o1[4 * g + 2] * rs * g1.z, o1[4 * g + 3] * rs * g1.w);
        *(u32x2*)(op + 8 * g) = w0; *(u32x2*)(op + 32 + 8 * g) = w1;
    }
}

constexpr int XA_KP = 136, XA_VP = 136;
__device__ __forceinline__ void xatt_stage(LAS unsigned char* lds, const bf16* KVm, int b, int mh, const int tid) {
    LAS bf16* Ks = (LAS bf16*)lds;
    LAS bf16* Vt = (LAS bf16*)(lds + 256 * XA_KP * 2);
    const bf16* base = KVm + (size_t)b * MEM_LEN * D_MODEL + mh * 128;
    u32x4 kv[8];
#pragma unroll
    for (int i = 0; i < 8; ++i) { const int p = tid + 512 * i, key = p >> 4, dg = p & 15; kv[i] = *(const u32x4*)(base + (size_t)key * D_MODEL + 8 * dg); }
#pragma unroll
    for (int i = 0; i < 8; ++i) { const int p = tid + 512 * i, key = p >> 4, dg = p & 15; *(LAS u32x4*)(Ks + key * XA_KP + 8 * dg) = kv[i]; }
#pragma unroll
    for (int i = 0; i < 8; ++i) { const int p = tid + 512 * i, key = p >> 4, dg = p & 15; kv[i] = *(const u32x4*)(base + (size_t)key * D_MODEL + 512 + 8 * dg); }
#pragma unroll
    for (int i = 0; i < 8; ++i) { const int p = tid + 512 * i, key = p >> 4, dg = p & 15; *(LAS u32x4*)(Vt + key * XA_VP + 8 * dg) = kv[i]; }
}
__device__ __forceinline__ void xatt_unit(LAS unsigned char* lds, const bf16* Qm, bf16* Om, int b, int mh, int qb, const int tid) {
    const int wave = tid >> 6, lane = tid & 63, j = lane & 31, hi = lane >> 5;
    LAS bf16* Ks = (LAS bf16*)lds;
    LAS bf16* Vt = (LAS bf16*)(lds + 256 * XA_KP * 2);
    const int qw = 256 * qb + 32 * wave;
    const size_t qrow = (size_t)b * SEQ + qw + j;
    bf16x8 qf[8];
    { const bf16* qp = Qm + qrow * MEM_W + mh * 128 + 8 * hi;
#pragma unroll
      for (int ks = 0; ks < 8; ++ks) qf[ks] = *(const bf16x8*)(qp + 16 * ks); }
    f32x16 o[4];
#pragma unroll
    for (int t = 0; t < 4; ++t)
#pragma unroll
        for (int r = 0; r < 16; ++r) o[t][r] = 0.f;
    float mrun = -1e30f, lsum = 0.f;
    const float scale = 0.08838834764831845f;
#pragma unroll 1
    for (int sub = 0; sub < 8; ++sub) {
        f32x16 acc;
#pragma unroll
        for (int r = 0; r < 16; ++r) acc[r] = 0.f;
#pragma unroll
        for (int ks = 0; ks < 8; ++ks) { const bf16x8 a = *(const LAS bf16x8*)(Ks + (32 * sub + j) * XA_KP + 16 * ks + 8 * hi); acc = MFMA32(a, qf[ks], acc); }
        float mx = -1e30f;
#pragma unroll
        for (int r = 0; r < 16; ++r) { acc[r] *= scale; mx = fmaxf(mx, acc[r]); }
        mx = half_max(mx);
        const float mnew = fmaxf(mrun, mx), corr = __expf(mrun - mnew);
        mrun = mnew; lsum *= corr;
        float p[16];
#pragma unroll
        for (int r = 0; r < 16; ++r) { p[r] = __expf(acc[r] - mnew); lsum += p[r]; }
#pragma unroll
        for (int t = 0; t < 4; ++t)
#pragma unroll
            for (int r = 0; r < 16; ++r) o[t][r] *= corr;
        u32x4 p0, p1;
        p0.x = pk2(p[0], p[1]); p0.y = pk2(p[2], p[3]); p0.z = pk2(p[4], p[5]); p0.w = pk2(p[6], p[7]);
        p1.x = pk2(p[8], p[9]); p1.y = pk2(p[10], p[11]); p1.z = pk2(p[12], p[13]); p1.w = pk2(p[14], p[15]);
        const bf16x8 pa0 = __builtin_bit_cast(bf16x8, p0), pa1 = __builtin_bit_cast(bf16x8, p1);
#pragma unroll
        for (int s = 0; s < 2; ++s) {
            const bf16x8 pb = s ? pa1 : pa0;
#pragma unroll
            for (int t = 0; t < 4; ++t) {
                const LAS bf16* vp = Vt + (32 * sub + 16 * s + 4 * hi + ((lane & 15) >> 2)) * XA_VP + 32 * t + 16 * ((lane >> 4) & 1) + 4 * (lane & 3);
                const s16x4 lo = lds_tr16(vp), hh = lds_tr16(vp + 8 * XA_VP); const bf16x8 va = __builtin_shufflevector(lo, hh, 0, 1, 2, 3, 4, 5, 6, 7);
                o[t] = MFMA32(va, pb, o[t]);
            }
        }
    }
    lsum = half_sum(lsum);
    const float inv = 1.f / lsum;
    bf16* op = Om + qrow * MEM_W + mh * 128 + 4 * hi;
#pragma unroll
    for (int t = 0; t < 4; ++t)
#pragma unroll
        for (int g = 0; g < 4; ++g) { u32x2 w; w.x = pk2(o[t][4 * g] * inv, o[t][4 * g + 1] * inv); w.y = pk2(o[t][4 * g + 2] * inv, o[t][4 * g + 3] * inv); *(u32x2*)(op + 32 * t + 8 * g) = w; }
}

constexpr int RW_P = 68;
constexpr int RW_ARR = 32 * RW_P * 4;
constexpr int RW_XWP = 72, RW_XGP = 168;
__device__ __forceinline__ void rw_lerp8(const u32x4 cu, const u32x4 pr, const LAS float* mu, float (&v)[8]) {
    const f32x4 m0 = *(const LAS f32x4*)mu, m1 = *(const LAS f32x4*)(mu + 4);
    float x, p;
    x = bflo(cu.x); p = bflo(pr.x); v[0] = x + (p - x) * m0.x;  x = bfhi(cu.x); p = bfhi(pr.x); v[1] = x + (p - x) * m0.y;
    x = bflo(cu.y); p = bflo(pr.y); v[2] = x + (p - x) * m0.z;  x = bfhi(cu.y); p = bfhi(pr.y); v[3] = x + (p - x) * m0.w;
    x = bflo(cu.z); p = bflo(pr.z); v[4] = x + (p - x) * m1.x;  x = bfhi(cu.z); p = bfhi(pr.z); v[5] = x + (p - x) * m1.y;
    x = bflo(cu.w); p = bflo(pr.w); v[6] = x + (p - x) * m1.z;  x = bfhi(cu.w); p = bfhi(pr.w); v[7] = x + (p - x) * m1.w;
}
__device__ __forceinline__ void rw_st_f32(LAS float* dst, const float (&v)[8]) { *(LAS f32x4*)dst = (f32x4){v[0], v[1], v[2], v[3]}; *(LAS f32x4*)(dst + 4) = (f32x4){v[4], v[5], v[6], v[7]}; }
__device__ __forceinline__ void rw_st_bf16(LAS bf16* dst, const float (&v)[8]) { u32x4 w; w.x = pk2(v[0], v[1]); w.y = pk2(v[2], v[3]); w.z = pk2(v[4], v[5]); w.w = pk2(v[6], v[7]); *(LAS u32x4*)dst = w; }
__device__ __forceinline__ void rwkv_head(LAS unsigned char* lds, const Args& a, const bf16* U, bf16* MIX, int b, int h, const int tid) {
    const int wave = __builtin_amdgcn_readfirstlane(tid >> 6), lane = tid & 63;
    LAS float* R = (LAS float*)(lds + 0 * RW_ARR); LAS float* Wd = (LAS float*)(lds + 1 * RW_ARR); LAS float* Kk = (LAS float*)(lds + 2 * RW_ARR); LAS float* Vv = (LAS float*)(lds + 3 * RW_ARR);
    LAS float* Aa = (LAS float*)(lds + 4 * RW_ARR); LAS float* Bb = (LAS float*)(lds + 5 * RW_ARR); LAS float* Gg = (LAS float*)(lds + 6 * RW_ARR); LAS float* Yy = (LAS float*)(lds + 7 * RW_ARR);
    LAS float* RK = (LAS float*)(lds + 8 * RW_ARR);
    LAS float* MU = (LAS float*)(lds + 8 * RW_ARR + 256);
    LAS bf16* XW = (LAS bf16*)(lds + 8 * RW_ARR + 256 + 2048); LAS bf16* XA = XW + 32 * RW_XWP; LAS bf16* XG = XA + 32 * RW_XWP;
    const int tok = tid >> 4, l16 = tid & 15, lo8 = (l16 < 8), l7 = l16 & 7;
    const int col0 = lo8 ? 64 * h + 8 * l7 : 512 + 64 * h + 8 * l7;
    const int col1 = lo8 ? 1024 + 64 * h + 8 * l7 : 1600 + 8 * l7;
    const int col2 = lo8 ? 1536 + 8 * l7 : 1664 + 8 * l7;
    const int col3 = 1728 + 8 * l16;
    __syncthreads();
    if (tid < 64) { const int i = tid >> 4, q = tid & 15; const bool q8 = q < 8; const int q7 = q & 7;
        const int cc = (i == 0) ? (q8 ? 64 * h + 8 * q7 : 512 + 64 * h + 8 * q7) : (i == 1) ? (q8 ? 1024 + 64 * h + 8 * q7 : 1600 + 8 * q7) : (i == 2) ? (q8 ? 1536 + 8 * q7 : 1664 + 8 * q7) : (q < 12 ? 1728 + 8 * q : 1728);
        const float* mu = a.in[I_MU] + cc;
#pragma unroll
        for (int e = 0; e < 8; ++e) MU[(i * 16 + q) * 8 + e] = mu[e]; }
    const int c4 = 4 * l16, gc = 64 * h + c4;
    const f32x4 kkw = *(const f32x4*)(a.in[I_KK] + gc), kaw = *(const f32x4*)(a.in[I_KA] + gc), rkw = *(const f32x4*)(a.in[I_RK] + gc);
    const f32x4 lg = *(const f32x4*)(a.in[I_LNG] + gc), lb = *(const f32x4*)(a.in[I_LNB] + gc);
    const int lkind = (wave < 4) ? (wave >> 1) : 2, lnt = wave & 1, lj = lane & 31, lhi = lane >> 5;
    const bool lactive = (wave < 4) || (wave >= 6);
    const int lnks = (lkind == 2) ? 10 : 4;
    const int lgcol = 64 * h + 32 * lnt + lj;
    bf16x8 wf[10];
    float lbias = 0.f;
    if (lactive) {
        const bf16* wb = (lkind == 0 ? (const bf16*)(a.ws + WS_LW2) + (size_t)lgcol * 64 : lkind == 1 ? (const bf16*)(a.ws + WS_LA2) + (size_t)lgcol * 64 : (const bf16*)(a.ws + WS_LG2) + (size_t)lgcol * 160) + 8 * lhi;
#pragma unroll
        for (int ks = 0; ks < 10; ++ks) if (ks < lnks) wf[ks] = *(const bf16x8*)(wb + 16 * ks);
        if (lkind == 0) lbias = a.in[I_W0][lgcol]; else if (lkind == 1) lbias = a.in[I_A0][lgcol];
    }
    const int srow = 8 * wave + 2 * (lane >> 4), kl = lane & 15;
    f32x4 pvv = {0.f, 0.f, 0.f, 0.f}, pgg = {0.f, 0.f, 0.f, 0.f}; float prk = 0.f;
    float S00 = 0.f, S01 = 0.f, S02 = 0.f, S03 = 0.f, S10 = 0.f, S11 = 0.f, S12 = 0.f, S13 = 0.f;
    const bf16* ubase = U + ((size_t)b * SEQ + tok) * LDU + RW_OFF;
    u32x4 cu0, cu1, cu2, cu3, pr0, pr1, pr2, pr3;
    const u32x4 z4 = (u32x4){0u, 0u, 0u, 0u};
    cu0 = *(const u32x4*)(ubase + col0); cu1 = *(const u32x4*)(ubase + col1); cu2 = *(const u32x4*)(ubase + col2); cu3 = (l16 < 12) ? *(const u32x4*)(ubase + col3) : z4;
    pr0 = z4; pr1 = z4; pr2 = z4; pr3 = z4;
    if (tok > 0) { pr0 = *(const u32x4*)(ubase - LDU + col0); pr1 = *(const u32x4*)(ubase - LDU + col1); pr2 = *(const u32x4*)(ubase - LDU + col2); if (l16 < 12) pr3 = *(const u32x4*)(ubase - LDU + col3); }
    __syncthreads();
    for (int c = 0; c < SEQ / 32; ++c) {
        const int t0 = 32 * c;
        {
            float v[8];
            rw_lerp8(cu0, pr0, MU + (0 * 16 + l16) * 8, v); rw_st_f32((lo8 ? R : Kk) + tok * RW_P + 8 * l7, v);
            rw_lerp8(cu1, pr1, MU + (1 * 16 + l16) * 8, v);
            if (lo8) rw_st_f32(Vv + tok * RW_P + 8 * l7, v); else rw_st_bf16(XA + tok * RW_XWP + 8 * l7, v);
            rw_lerp8(cu2, pr2, MU + (2 * 16 + l16) * 8, v);
            { const float s0 = lo8 ? -2.f : -1.f, s1 = lo8 ? 2.f : 1.f, s2 = lo8 ? -1.f : 0.f;
#pragma unroll
              for (int i = 0; i < 8; ++i) { const float xx = fminf(fmaxf(v[i], -30.f), 30.f); v[i] = fmaf(s1, __builtin_amdgcn_rcpf(1.f + __expf(s0 * xx)), s2); }
              rw_st_bf16((lo8 ? XW + tok * RW_XWP : XG + tok * RW_XGP) + 8 * l7, v); }
            if (l16 < 12) {
                rw_lerp8(cu3, pr3, MU + (3 * 16 + l16) * 8, v);
#pragma unroll
                for (int i = 0; i < 8; ++i) v[i] = __builtin_amdgcn_rcpf(1.f + __expf(-v[i]));
                rw_st_bf16(XG + tok * RW_XGP + 64 + 8 * l16, v); }
        }
        LDS_BARRIER();
        if (c + 1 < SEQ / 32) {
            const bf16* ub = ubase + (size_t)(t0 + 32) * LDU;
            cu0 = *(const u32x4*)(ub + col0); cu1 = *(const u32x4*)(ub + col1); cu2 = *(const u32x4*)(ub + col2); if (l16 < 12) cu3 = *(const u32x4*)(ub + col3);
            pr0 = *(const u32x4*)(ub - LDU + col0); pr1 = *(const u32x4*)(ub - LDU + col1); pr2 = *(const u32x4*)(ub - LDU + col2); if (l16 < 12) pr3 = *(const u32x4*)(ub - LDU + col3);
        }
        if (lactive) {
            const LAS bf16* xa = (lkind == 0 ? XW + lj * RW_XWP : lkind == 1 ? XA + lj * RW_XWP : XG + lj * RW_XGP) + 8 * lhi;
            f32x16 acc;
#pragma unroll
            for (int r = 0; r < 16; ++r) acc[r] = 0.f;
#pragma unroll
            for (int ks = 0; ks < 10; ++ks) if (ks < lnks) { const bf16x8 av = *(const LAS bf16x8*)(xa + 16 * ks); acc = MFMA32(av, wf[ks], acc); }
            const int col = 32 * lnt + lj;
            if (lkind == 0) {
#pragma unroll
                for (int r = 0; r < 16; ++r) { const int tk = 8 * (r >> 2) + 4 * lhi + (r & 3); const float x = lbias + acc[r];
                    const float w = -__logf(1.f + __expf(-x)) - 0.5f; Wd[tk * RW_P + col] = __expf(-__expf(w)); }
            } else if (lkind == 1) {
#pragma unroll
                for (int r = 0; r < 16; ++r) { const int tk = 8 * (r >> 2) + 4 * lhi + (r & 3); Bb[tk * RW_P + col] = __builtin_amdgcn_rcpf(1.f + __expf(-(lbias + acc[r]))); }
            } else {
#pragma unroll
                for (int r = 0; r < 16; ++r) { const int tk = 8 * (r >> 2) + 4 * lhi + (r & 3); Gg[tk * RW_P + col] = acc[r]; }
            }
        }
        LDS_BARRIER();
        {
            if (c > 0) {
                f32x4 y; { const LAS float* yq = (const LAS float*)(lds + 94208) + (tok * 32 + 2 * l16) * 8; const f32x4 v0 = *(const LAS f32x4*)yq, v1 = *(const LAS f32x4*)(yq + 4), v2 = *(const LAS f32x4*)(yq + 8), v3 = *(const LAS f32x4*)(yq + 12);
                  y = (f32x4){(v0.x + v0.z) + (v1.x + v1.z), (v0.y + v0.w) + (v1.y + v1.w), (v2.x + v2.z) + (v3.x + v3.z), (v2.y + v2.w) + (v3.y + v3.w)}; }
                const float mean = red16((y.x + y.y) + (y.z + y.w)) * (1.f / 64.f);
                const f32x4 d = y - mean;
                const float var = red16((d.x * d.x + d.y * d.y) + (d.z * d.z + d.w * d.w)) * (1.f / 64.f);
                const float rs = rsqrtf(var + LNX_EPS);
                const f32x4 o = (d * rs * lg + lb + prk * pvv) * pgg;
                u32x2 w; w.x = pk2(o.x, o.y); w.y = pk2(o.z, o.w);
                *(u32x2*)(MIX + ((size_t)b * SEQ + t0 - 32 + tok) * D_MODEL + 512 + gc) = w;
            }
            const f32x4 kr = *(LAS f32x4*)(Kk + tok * RW_P + c4), al = *(LAS f32x4*)(Bb + tok * RW_P + c4), rr = *(LAS f32x4*)(R + tok * RW_P + c4);
            pvv = *(LAS f32x4*)(Vv + tok * RW_P + c4); pgg = *(LAS f32x4*)(Gg + tok * RW_P + c4);
            f32x4 kkv = kr * kkw;
            const float ssq = red16((kkv.x * kkv.x + kkv.y * kkv.y) + (kkv.z * kkv.z + kkv.w * kkv.w));
            const float inv = 1.f / fmaxf(sqrtf(ssq), 1e-12f);
            kkv = kkv * inv;
            const f32x4 km = kr * (1.f + (al - 1.f) * kaw);
            *(LAS f32x4*)(Aa + tok * RW_P + c4) = -kkv;
            *(LAS f32x4*)(Bb + tok * RW_P + c4) = kkv * al;
            *(LAS f32x4*)(Kk + tok * RW_P + c4) = km;
            const f32x4 pr = rr * km * rkw;
            prk = red16((pr.x + pr.y) + (pr.z + pr.w));
        }
        LDS_BARRIER();
        {
            const unsigned ak = (unsigned)(size_t)lds + 16u * kl, av = (unsigned)(size_t)lds + 3u * RW_ARR + 4u * srow;
            const unsigned yaddr = (unsigned)(size_t)(lds + 94208 + ((srow >> 1) * 4 + (kl >> 2)) * 8);
            const unsigned ystep = 1024u;
#define RW_LDS_STEP(tt) do { const unsigned _a = ak + (unsigned)((tt) * RW_P * 4), _v = av + (unsigned)((tt) * RW_P * 4); \
                asm volatile("ds_read_b128 %0, %1 offset:34816" : "=v"(na) : "v"(_a)); asm volatile("ds_read_b128 %0, %1 offset:8704" : "=v"(nw) : "v"(_a)); \
                asm volatile("ds_read_b128 %0, %1 offset:43520" : "=v"(nb) : "v"(_a)); asm volatile("ds_read_b128 %0, %1 offset:17408" : "=v"(nk) : "v"(_a)); \
                asm volatile("ds_read_b128 %0, %1" : "=v"(nr) : "v"(_a)); asm volatile("ds_read_b64 %0, %1" : "=v"(nv) : "v"(_v)); } while (0)
            f32x4 na, nw, nb, nk, nr; f32x2 nv;
            RW_LDS_STEP(0);
            asm volatile("s_waitcnt lgkmcnt(0)" : "+v"(na), "+v"(nw), "+v"(nb), "+v"(nk), "+v"(nr), "+v"(nv));
#pragma unroll 4
            for (int t = 0; t < 32; ++t) {
                const f32x4 a4 = na, w4 = nw, b4 = nb, k4 = nk, r4 = nr; const f32x2 v2 = nv;
                RW_LDS_STEP((t + 1) & 31);
                float sa0 = fmaf(S03, a4.w, fmaf(S02, a4.z, fmaf(S01, a4.y, S00 * a4.x)));
                float sa1 = fmaf(S13, a4.w, fmaf(S12, a4.z, fmaf(S11, a4.y, S10 * a4.x)));
                sa0 = red16(sa0); sa1 = red16(sa1);
                S00 = fmaf(v2.x, k4.x, fmaf(sa0, b4.x, S00 * w4.x)); S01 = fmaf(v2.x, k4.y, fmaf(sa0, b4.y, S01 * w4.y));
                S02 = fmaf(v2.x, k4.z, fmaf(sa0, b4.z, S02 * w4.z)); S03 = fmaf(v2.x, k4.w, fmaf(sa0, b4.w, S03 * w4.w));
                S10 = fmaf(v2.y, k4.x, fmaf(sa1, b4.x, S10 * w4.x)); S11 = fmaf(v2.y, k4.y, fmaf(sa1, b4.y, S11 * w4.y));
                S12 = fmaf(v2.y, k4.z, fmaf(sa1, b4.z, S12 * w4.z)); S13 = fmaf(v2.y, k4.w, fmaf(sa1, b4.w, S13 * w4.w));
                float y0 = fmaf(S03, r4.w, fmaf(S02, r4.z, fmaf(S01, r4.y, S00 * r4.x)));
                float y1 = fmaf(S13, r4.w, fmaf(S12, r4.z, fmaf(S11, r4.y, S10 * r4.x)));
                asm volatile("" : "+v"(y0), "+v"(y1));
                y0 += dppf<0xB1>(y0); y1 += dppf<0xB1>(y1); y0 += dppf<0x4E>(y0); y1 += dppf<0x4E>(y1);
                asm volatile("" : "+v"(y0), "+v"(y1));
                { const f32x2 yv = {y0, y1}; asm volatile("ds_write_b64 %0, %1" :: "v"(yaddr + (unsigned)(t * ystep)), "v"(yv)); }
                asm volatile("s_waitcnt lgkmcnt(0)" : "+v"(na), "+v"(nw), "+v"(nb), "+v"(nk), "+v"(nr), "+v"(nv));
            }
        }
        LDS_BARRIER();
    }
    {
        f32x4 y; { const LAS float* yq = (const LAS float*)(lds + 94208) + (tok * 32 + 2 * l16) * 8; const f32x4 v0 = *(const LAS f32x4*)yq, v1 = *(const LAS f32x4*)(yq + 4), v2 = *(const LAS f32x4*)(yq + 8), v3 = *(const LAS f32x4*)(yq + 12);
                  y = (f32x4){(v0.x + v0.z) + (v1.x + v1.z), (v0.y + v0.w) + (v1.y + v1.w), (v2.x + v2.z) + (v3.x + v3.z), (v2.y + v2.w) + (v3.y + v3.w)}; }
        const float mean = red16((y.x + y.y) + (y.z + y.w)) * (1.f / 64.f);
        const f32x4 d = y - mean;
        const float var = red16((d.x * d.x + d.y * d.y) + (d.z * d.z + d.w * d.w)) * (1.f / 64.f);
        const float rs = rsqrtf(var + LNX_EPS);
        const f32x4 o = (d * rs * lg + lb + prk * pvv) * pgg;
        u32x2 w; w.x = pk2(o.x, o.y); w.y = pk2(o.z, o.w);
        *(u32x2*)(MIX + ((size_t)b * SEQ + SEQ - 32 + tok) * D_MODEL + 512 + gc) = w;
    }
    __syncthreads();
}

#define XB_TMO      128
#define XB_XCNT(j)  (256  + 64 * (j))
#define XB_XSUB(j)  (1280 + 64 * (j))
#define XB_XGEN(j)  (2304 + 64 * (j))
#define XB_TOP      3328
#define XB_TOPGEN   3392
#define XCD_BAR_WORDS 3456
#define XB_SPIN_CAP (1u << 18)

__device__ __forceinline__ unsigned xb_ld(unsigned* p)              { return __hip_atomic_load(p, __ATOMIC_RELAXED, __HIP_MEMORY_SCOPE_AGENT); }
__device__ __forceinline__ unsigned xb_add(unsigned* p, unsigned v) { return __hip_atomic_fetch_add(p, v, __ATOMIC_RELAXED, __HIP_MEMORY_SCOPE_AGENT); }
__device__ __forceinline__ unsigned xb_xcc_id() { return (unsigned)__builtin_amdgcn_s_getreg((3 << 11) | 20) & 0xFu; }
#define XB_SPIN(cond, bar) do { unsigned _sp = 0; while (cond) { __builtin_amdgcn_s_sleep(1); \
    if ((++_sp & 255u) == 0u) { if (xb_ld(&(bar)[XB_TMO])) break; if (_sp > XB_SPIN_CAP) { atomicAdd(&(bar)[XB_TMO], 1u); break; } } } } while (0)

struct XcdBarrier {
    unsigned* bar; unsigned x;
    volatile LAS unsigned* st;
};

__device__ __forceinline__ XcdBarrier xcd_barrier_post(unsigned* bar, volatile LAS unsigned* st) {
    XcdBarrier b; b.bar = bar; b.x = xb_xcc_id(); b.st = st;
    if (threadIdx.x == 0) (void)xb_add(&bar[XB_XCNT(b.x)], 1u);
    return b;
}
__device__ __forceinline__ void xcd_barrier_complete(unsigned* bar, unsigned x, unsigned& nloc, unsigned& nx) {
    const unsigned G = gridDim.x * gridDim.y * gridDim.z;
    unsigned sum, cnt, mine, sp = 0u;
    for (;;) {
        sum = 0u; cnt = 0u; mine = 0u;
#pragma unroll
        for (unsigned j = 0; j < 16; ++j) { const unsigned c = xb_ld(&bar[XB_XCNT(j)]); sum += c; cnt += (c > 0u) ? 1u : 0u; mine = (j == x) ? c : mine; }
        if (sum == G) break;
        __builtin_amdgcn_s_sleep(1);
        if ((++sp & 255u) == 0u) { if (xb_ld(&bar[XB_TMO])) break; if (sp > XB_SPIN_CAP) { atomicAdd(&bar[XB_TMO], 1u); break; } }
    }
    nloc = mine > 0u ? mine : 1u; nx = cnt > 0u ? cnt : 1u;
}

__device__ __forceinline__ void xcd_barrier(const XcdBarrier& b) {
    asm volatile("s_waitcnt vmcnt(0)" ::: "memory");
    __syncthreads();
    if (threadIdx.x == 0) {
        unsigned* bar = b.bar;
        __builtin_amdgcn_s_waitcnt(0);
        unsigned nloc = b.st[0], nx = b.st[1];
        if (nloc == 0u) { xcd_barrier_complete(bar, b.x, nloc, nx); b.st[0] = nloc; b.st[1] = nx; }
        const unsigned old = xb_add(&bar[XB_XSUB(b.x)], 1u);
        const unsigned gen = old / nloc;
        if (old + 1u == (gen + 1u) * nloc) {
            __builtin_amdgcn_fence(__ATOMIC_RELEASE, "agent");
            asm volatile("s_waitcnt vmcnt(0)" ::: "memory");
            const unsigned og = xb_add(&bar[XB_TOP], 1u);
            const unsigned tg = og / nx;
            if (og + 1u == (tg + 1u) * nx) xb_add(&bar[XB_TOPGEN], 1u);
            else XB_SPIN(xb_ld(&bar[XB_TOPGEN]) == tg, bar);
            __builtin_amdgcn_fence(__ATOMIC_ACQUIRE, "agent");
            xb_add(&bar[XB_XGEN(b.x)], 1u);
            asm volatile("s_waitcnt vmcnt(0)" ::: "memory");
        } else {
            XB_SPIN(xb_ld(&bar[XB_XGEN(b.x)]) == gen, bar);
            __builtin_amdgcn_fence(__ATOMIC_ACQUIRE, "agent");
            asm volatile("s_waitcnt vmcnt(0)" ::: "memory");
        }
    }
    __syncthreads();
}

__device__ __forceinline__ void sub_barrier(unsigned* ctr, unsigned n) {
    asm volatile("s_waitcnt vmcnt(0)" ::: "memory");
    __syncthreads();
    if (threadIdx.x == 0) {
        __builtin_amdgcn_fence(__ATOMIC_RELEASE, "agent");
        asm volatile("s_waitcnt vmcnt(0)" ::: "memory");
        (void)__hip_atomic_fetch_add(ctr, 1u, __ATOMIC_RELAXED, __HIP_MEMORY_SCOPE_AGENT);
        unsigned sp = 0u;
        while (__hip_atomic_load(ctr, __ATOMIC_RELAXED, __HIP_MEMORY_SCOPE_AGENT) < n) { __builtin_amdgcn_s_sleep(2); if (++sp > (1u << 22)) break; }
        __builtin_amdgcn_fence(__ATOMIC_ACQUIRE, "agent");
        asm volatile("s_waitcnt vmcnt(0)" ::: "memory");
    }
    __syncthreads();
}
constexpr int MIXA_C0 = 1536;
constexpr int SUBBAR_WORD = 8192;
constexpr int N_PHASES = 16;
constexpr int XB_LDS_OFF = LDS_BYTES - 64, XB_WS_WORD = 4096;
__global__ void __launch_bounds__(NTHREADS, 2) mega_fwd(Args args) {
    extern __shared__ __attribute__((aligned(16))) unsigned char lds_raw[];
    LAS unsigned char* lds0 = (LAS unsigned char*)lds_raw;
    const Args* ap0 = (const Args*)__builtin_amdgcn_kernarg_segment_ptr();
    const int ph_lo = ap0->ph_lo, ph_hi = ap0->ph_hi;
    if (ph_hi - ph_lo > 1) {
        volatile LAS unsigned* bst = (volatile LAS unsigned*)(lds0 + XB_LDS_OFF);
        if (threadIdx.x < 2) bst[threadIdx.x] = 0u;
        __syncthreads();
        (void)xcd_barrier_post((unsigned*)(ap0->ws) + XB_WS_WORD, bst);
    }
    for (int ph = ph_lo; ph < ph_hi; ++ph) {
        const Args* ap = ap0; asm volatile("" : "+s"(ap));
        const Args& A = *ap;
        int tid = threadIdx.x; asm volatile("" : "+v"(tid));
        int G = gridDim.x, bid = blockIdx.x; asm volatile("" : "+s"(G), "+s"(bid));
        LAS unsigned char* lds = lds0; asm volatile("" : "+s"(lds));
        const int lane = tid & 63, wave = __builtin_amdgcn_readfirstlane(tid >> 6);
        const int gw = bid * NWAVES + wave, NGW = G * NWAVES;
        unsigned char* ws = A.ws;
        bool is_gemm = false; pg8::Gemm g{nullptr, nullptr, 0, 0, 0}; pg8::EpiU E{nullptr, 0, 0}; int gG = G, gc = bid;
        switch (ph) {
        case 0: prologue<0>(A, lds, gw, NGW, wave, lane); break;
        case 1: g = pg8::Gemm{(const bf16*)(ws + WS_XN), (const bf16*)(ws + WS_W1IN), M_TOK, 2 * D_FF, D_MODEL}; E = pg8::EpiU{(bf16*)(ws + WS_HU), D_FF, 1}; is_gemm = true; break;
        case 2: g = pg8::Gemm{(const bf16*)(ws + WS_HU), (const bf16*)(ws + WS_W1OUT), M_TOK, D_MODEL, D_FF}; E = pg8::EpiU{(bf16*)(ws + WS_Y), D_MODEL, 0}; is_gemm = true; break;
        case 3: norm_pass<false, true>((const bf16*)(ws + WS_Y), A.in[I_X], ws + WS_HB, 0.5f, A.in[I_F1POST], A.in[I_MIXPRE], (bf16*)(ws + WS_XN), gw, NGW, lane); break;
        case 4: g = pg8::Gemm{(const bf16*)(ws + WS_XN), (const bf16*)(ws + WS_WMIXIN) + (size_t)MIXA_C0 * D_MODEL, M_TOK, LDU - MIXA_C0, D_MODEL}; E = pg8::EpiU{(bf16*)(ws + WS_HU) + MIXA_C0, LDU, 0}; is_gemm = true; break;
        case 5: { const int nR = (G >= 256) ? 128 : (G / 2 > 0 ? G / 2 : 1);
                  if (bid >= nR) { g = pg8::Gemm{(const bf16*)(ws + WS_XN), (const bf16*)(ws + WS_WMIXIN), M_TOK, MIXA_C0, D_MODEL}; E = pg8::EpiU{(bf16*)(ws + WS_HU), LDU, 0}; is_gemm = true; gG = G - nR; gc = bid - nR; } } break;
        case 6: {
            const bf16* HU = (const bf16*)(ws + WS_HU); bf16* XN = (bf16*)(ws + WS_Y);
            const int nR = (G >= 256) ? 128 : (G / 2 > 0 ? G / 2 : 1);
            if (bid < nR) { for (int hd = bid; hd < BATCH * 8; hd += nR) rwkv_head(lds, A, HU, XN, hd >> 3, hd & 7, tid); }
            else { if (ph_hi - ph_lo > 1) sub_barrier((unsigned*)(ws) + SUBBAR_WORD, (unsigned)(G - nR));
                   for (int u = bid - nR; u < BATCH * 8 * 8; u += G - nR) { const int bh = u & 127, qb = 7 - (u >> 7); sb_unit(lds, HU, XN, A.in[I_SBG], bh >> 3, bh & 7, qb, tid); }
                   __syncthreads();
                   { const int sb = bid - nR, nsb = G - nR;
                     if (nsb == 128) { if (sb < 64) prologue<1>(A, lds, sb * NWAVES + wave, 2048, wave, lane);
                                       else { for (int k = 0; k < 3; ++k) { prologue<1>(A, lds, 512 + ((sb - 64) * NWAVES + wave) * 3 + k, 2048, wave, lane); } } }
                     else prologue<1>(A, lds, sb * NWAVES + wave, nsb * NWAVES, wave, lane); }
                   __syncthreads();
                   g = pg8::Gemm{(const bf16*)(ws + WS_MEMN), (const bf16*)(ws + WS_WKV), M_MEM, D_MODEL, D_MODEL}; E = pg8::EpiU{(bf16*)(ws + WS_KVM), D_MODEL, 0}; is_gemm = true; gG = G - nR; gc = bid - nR; }
        } break;
        case 7: g = pg8::Gemm{(const bf16*)(ws + WS_Y), (const bf16*)(ws + WS_WMIXOUT), M_TOK, D_MODEL, D_MODEL}; E = pg8::EpiU{(bf16*)(ws + WS_XN), D_MODEL, 0}; is_gemm = true; break;
        case 8: norm_pass<true, true>((const bf16*)(ws + WS_XN), ws + WS_HB, ws + WS_HB, 1.0f, A.in[I_MIXPOST], A.in[I_MEMPRE], (bf16*)(ws + WS_XN), gw, NGW, lane); break;
        case 9: g = pg8::Gemm{(const bf16*)(ws + WS_XN), (const bf16*)(ws + WS_WQ), M_TOK, MEM_W, D_MODEL}; E = pg8::EpiU{(bf16*)(ws + WS_QM), MEM_W, 0}; is_gemm = true; break;
        case 10: for (int pu = bid; pu < BATCH * 4 * 4; pu += G) { const int bm = pu >> 2, q0 = pu & 3, b = bm >> 2, mh = bm & 3;
                     __syncthreads(); xatt_stage(lds, (const bf16*)(ws + WS_KVM), b, mh, tid); __syncthreads();
                     xatt_unit(lds, (const bf16*)(ws + WS_QM), (bf16*)(ws + WS_OM), b, mh, q0, tid); xatt_unit(lds, (const bf16*)(ws + WS_QM), (bf16*)(ws + WS_OM), b, mh, q0 + 4, tid); } break;
        case 11: g = pg8::Gemm{(const bf16*)(ws + WS_OM), (const bf16*)(ws + WS_WO), M_TOK, D_MODEL, MEM_W}; E = pg8::EpiU{(bf16*)(ws + WS_Y), D_MODEL, 0}; is_gemm = true; break;
        case 12: norm_pass<true, true>((const bf16*)(ws + WS_Y), ws + WS_HB, ws + WS_HB, 1.0f, A.in[I_MEMPOST], A.in[I_F2PRE], (bf16*)(ws + WS_XN), gw, NGW, lane); break;
        case 13: g = pg8::Gemm{(const bf16*)(ws + WS_XN), (const bf16*)(ws + WS_W2IN), M_TOK, 2 * D_FF, D_MODEL}; E = pg8::EpiU{(bf16*)(ws + WS_HU), D_FF, 1}; is_gemm = true; break;
        case 14: g = pg8::Gemm{(const bf16*)(ws + WS_HU), (const bf16*)(ws + WS_W2OUT), M_TOK, D_MODEL, D_FF}; E = pg8::EpiU{(bf16*)(ws + WS_Y), D_MODEL, 0}; is_gemm = true; break;
        case 15: norm_pass<true, false>((const bf16*)(ws + WS_Y), ws + WS_HB, A.out, 0.5f, A.in[I_F2POST], nullptr, nullptr, gw, NGW, lane); break;
        default: break;
        }
        if (is_gemm) { pg8::StaticOrder S; S.init(g.M, g.N, gG, gc); pg8::gemm_phase<pg8::EpiU, pg8::StaticOrder, true, true>(lds, g, S, E, tid); }
        if (ph + 1 < ph_hi && ph != 5) {
            if (ph_hi > N_PHASES) { __syncthreads(); cg::this_grid().sync(); }
            else { XcdBarrier xb; xb.bar = (unsigned*)(A.ws) + XB_WS_WORD; xb.x = xb_xcc_id(); xb.st = (volatile LAS unsigned*)(lds + XB_LDS_OFF); xcd_barrier(xb); }
        }
    }
}

#ifndef MK_ONE_LAUNCH
#define MK_ONE_LAUNCH 1
#endif
extern "C" void kernel_launch(void* const* d_in, const int* in_sizes, int n_in, void* d_out, int out_size, void* d_ws, size_t ws_size, hipStream_t stream) {
    static int grid = 0;
    if (grid == 0) {
        if (n_in != N_IN || out_size != M_TOK * D_MODEL || ws_size < WS_END) { fprintf(stderr, "kernel_launch: unexpected shapes (n_in %d out %d ws %zu)\n", n_in, out_size, ws_size); grid = -1; return; }
        int dev = 0, cus = 0, per_cu = 0;
        if (hipGetDevice(&dev) != hipSuccess || hipDeviceGetAttribute(&cus, hipDeviceAttributeMultiprocessorCount, dev) != hipSuccess) { grid = -1; return; }
        if (hipFuncSetAttribute((const void*)mega_fwd, hipFuncAttributeMaxDynamicSharedMemorySize, LDS_BYTES) != hipSuccess) { fprintf(stderr, "kernel_launch: hipFuncSetAttribute failed\n"); grid = -1; return; }
        if (hipOccupancyMaxActiveBlocksPerMultiprocessor(&per_cu, (const void*)mega_fwd, NTHREADS, LDS_BYTES) != hipSuccess || per_cu < 1) { fprintf(stderr, "kernel_launch: occupancy query gave %d\n", per_cu); per_cu = 1; }
        (void)hipGetLastError();
        grid = cus;
    }
    if (grid < 0) return;
    if (hipMemsetAsync(d_ws, 0, 1u << 20, stream) != hipSuccess) { fprintf(stderr, "kernel_launch: memset of the control words failed\n"); return; }
    Args a{};
    for (int i = 0; i < N_IN; ++i) a.in[i] = (const float*)d_in[i];
    a.out = (float*)d_out; a.ws = (unsigned char*)d_ws;
#if MK_ONE_LAUNCH
    a.ph_lo = 0; a.ph_hi = N_PHASES;
    void* kargs[] = {&a};
    hipError_t e = hipLaunchCooperativeKernel((const void*)mega_fwd, dim3(grid), dim3(NTHREADS), kargs, LDS_BYTES, stream);
    if (e != hipSuccess) fprintf(stderr, "cooperative launch failed: %s (grid %d)\n", hipGetErrorString(e), grid);
#else
    for (int p = 0; p < N_PHASES; ++p) { a.ph_lo = p; a.ph_hi = p + 1; hipLaunchKernelGGL(mega_fwd, dim3(grid), dim3(NTHREADS), LDS_BYTES, stream, a); }
#endif
}
```

```cpp
#include <hip/hip_runtime.h>
#include <hip/hip_cooperative_groups.h>
#include <cstdio>
#include <cstdint>
namespace cg = cooperative_groups;
namespace pg8 {
#define PG8_LAS __attribute__((address_space(3)))
typedef unsigned short bf16_t;
typedef short bf16x8 __attribute__((ext_vector_type(8)));
typedef float f32x4 __attribute__((ext_vector_type(4)));
typedef unsigned u32x4 __attribute__((ext_vector_type(4)));
constexpr int BM = 256, BK = 64, HALF = 128, HTB = HALF * BK * 2  , STAGE_BYTES = 8 * HTB, NXCD = 8, WGM = 8;

__host__ __device__ __forceinline__ int lds_byte(int r, int c) { const int st = (r >> 4) * 2 + (c >> 5), rr = r & 15, cc = c & 31, ob = rr * 64 + cc * 2; return st * 1024 + (ob ^ (((ob >> 9) & 1) << 5)); }
__host__ __device__ __forceinline__ void stage_rc(int b, int& R, int& C) { const int st = b / 1024, sb = b % 1024, swz = sb ^ (((sb >> 9) & 1) << 5); R = (st >> 1) * 16 + swz / 64; C = (st & 1) * 32 + (swz % 64) / 2; }
__host__ __device__ __forceinline__ int perm32(int rho) { const int n = rho >> 4, i = rho & 15; return 8 * (i >> 2) + 4 * n + (i & 3); }

struct Unit { int pm, pn; };
struct Gemm { const bf16_t* A; const bf16_t* Bt; int M, N, K; };

struct StaticOrder {
    int nM, nN, nwg, G, c;
    __host__ __device__ void init(int M, int N, int G_, int c_) { nM = M / BM; nN = N / BM; nwg = nM * nN; G = G_; c = c_; }
    __host__ __device__ bool next(int i, Unit& u) const {
        const long L = (long)i * G + c; if (L >= nwg) return false;
        int wgid = (int)L; { const int q = nwg / NXCD, r = nwg % NXCD, xcd = wgid % NXCD, off = wgid / NXCD; wgid = (xcd < r ? xcd * (q + 1) : r * (q + 1) + (xcd - r) * q) + off; }
        const int nig = WGM * nN, gid = wgid / nig, fm = gid * WGM, gsz = (nM - fm) < WGM ? (nM - fm) : WGM;
        u.pm = fm + ((wgid % nig) % gsz); u.pn = (wgid % nig) / gsz; return true;
    }
    __device__ __forceinline__ void a_ready(const Unit&) const {}
    __device__ __forceinline__ void done(const Unit&) const {}
};
__device__ __forceinline__ unsigned cvt_pk_bf16(float lo, float hi) { unsigned r; asm volatile("v_cvt_pk_bf16_f32 %0, %1, %2" : "=v"(r) : "v"(lo), "v"(hi)); return r; }
typedef float f32x2 __attribute__((ext_vector_type(2)));
struct EpiU {
    static constexpr bool PERM = true, AFTER_DRAIN = false;
    bf16_t* O; int ldc; int mode;
    __device__ __forceinline__ void operator()(const f32x4 (&acc)[2][2][4][2], const Unit& u, int wr, int wc, int fr, int fq) const {
        const int row0 = u.pm * BM + wr * 64 + fr;
        if (mode == 0) {
            const int col0 = u.pn * BM + wc * 32 + 8 * fq;
#pragma unroll
            for (int ai = 0; ai < 2; ++ai)
#pragma unroll
                for (int m = 0; m < 4; ++m) { bf16_t* rowp = O + (size_t)(row0 + ai * HALF + m * 16) * ldc + col0;
#pragma unroll
                    for (int bj = 0; bj < 2; ++bj) { const f32x4 v0 = acc[ai][bj][m][0], v1 = acc[ai][bj][m][1];
                        u32x4 w; w.x = cvt_pk_bf16(v0[0], v0[1]); w.y = cvt_pk_bf16(v0[2], v0[3]); w.z = cvt_pk_bf16(v1[0], v1[1]); w.w = cvt_pk_bf16(v1[2], v1[3]);
                        *(u32x4*)(rowp + bj * HALF) = w; } }
        } else {
            const int col0 = u.pn * HALF + wc * 32 + 8 * fq;
#pragma unroll
            for (int ai = 0; ai < 2; ++ai)
#pragma unroll
                for (int m = 0; m < 4; ++m) { bf16_t* rowp = O + (size_t)(row0 + ai * HALF + m * 16) * ldc + col0;
                    float hv[8];
#pragma unroll
                    for (int n = 0; n < 2; ++n)
#pragma unroll
                        for (int j = 0; j < 4; ++j) { const float g = acc[ai][0][m][n][j], up = acc[ai][1][m][n][j];
                            hv[4 * n + j] = g * __builtin_amdgcn_rcpf(1.f + __expf(-g)) * up; }
                    u32x4 w; w.x = cvt_pk_bf16(hv[0], hv[1]); w.y = cvt_pk_bf16(hv[2], hv[3]); w.z = cvt_pk_bf16(hv[4], hv[5]); w.w = cvt_pk_bf16(hv[6], hv[7]);
                    *(u32x4*)rowp = w; }
        }
    }
};
template <class Epi, class Sched, bool ALIGN_EPI = false, bool SP2 = false>
__device__ __forceinline__ void gemm_phase(PG8_LAS unsigned char* lds, const Gemm g, const Sched& S, const Epi& E, const int tid) {
    const int wid = __builtin_amdgcn_readfirstlane(tid >> 6), lane = tid & 63, wr = wid >> 2, wc = wid & 3, fr = lane & 15, fq = lane >> 4;
    const int K = g.K, nt = K / BK;
    unsigned voffA[2], voffB[2];
#pragma unroll
    for (int i = 0; i < 2; ++i) { int R, C; stage_rc(tid * 16 + i * 8192, R, C); const int Rb = Epi::PERM ? ((R & ~31) + perm32(R & 31)) : R;
        voffA[i] = (unsigned)(R * K + C) * 2u; voffB[i] = (unsigned)(Rb * K + C) * 2u; }
    const size_t kstep = (size_t)(BK * 2);
    const size_t hstep = (size_t)HALF * K * 2;
    const size_t tstep = 2 * hstep;
    const unsigned ldsw = (unsigned)wid * 1024u;
    const int aoff = lds_byte(wr * 64 + fr, fq * 8), boff = lds_byte(wc * 32 + fr, fq * 8);
#define PG8_SA(b, h) (((b) * 2 + (h)) * HTB)
#define PG8_SB(b, h) ((4 + (b) * 2 + (h)) * HTB)
#define PG8_STAGE(bufoff, gbase, voff) do { _Pragma("unroll") for (int _i = 0; _i < 2; ++_i) \
        __builtin_amdgcn_global_load_lds((const unsigned*)((const char*)(gbase) + (voff)[_i]), (PG8_LAS unsigned*)(lds + (bufoff) + ldsw + _i * 8192), 16, 0, 0); } while (0)
#define PG8_LDA(dst, b, h) do { _Pragma("unroll") for (int m = 0; m < 4; ++m) _Pragma("unroll") for (int k = 0; k < 2; ++k) dst[m][k] = *(const PG8_LAS bf16x8*)(lds + PG8_SA(b, h) + aoff + m * 2048 + k * 1024); } while (0)
#define PG8_LDB(dst, b, h) do { _Pragma("unroll") for (int n = 0; n < 2; ++n) _Pragma("unroll") for (int k = 0; k < 2; ++k) dst[n][k] = *(const PG8_LAS bf16x8*)(lds + PG8_SB(b, h) + boff + n * 2048 + k * 1024); } while (0)
#define PG8_MMA(ai, bj, At, Bt) do { __builtin_amdgcn_s_setprio(1); _Pragma("unroll") for (int m = 0; m < 4; ++m) _Pragma("unroll") for (int n = 0; n < 2; ++n) _Pragma("unroll") for (int k = 0; k < 2; ++k) \
        acc[ai][bj][m][n] = __builtin_amdgcn_mfma_f32_16x16x32_bf16(Bt[n][k], At[m][k], acc[ai][bj][m][n], 0, 0, 0); __builtin_amdgcn_s_setprio(0); } while (0)
#define PG8_WAIT_V(n) asm volatile("s_waitcnt vmcnt(" #n ")" ::: "memory")
#define PG8_WAIT_L(n) asm volatile("s_waitcnt lgkmcnt(" #n ")" ::: "memory")
#define PG8_BAR __builtin_amdgcn_s_barrier()
#define PG8_SCHED __builtin_amdgcn_sched_barrier(0)
    Unit cur, nxt; int ui = 0;
    if (!S.next(0, cur)) return;
    f32x4 acc[2][2][4][2];
#pragma unroll
    for (int a = 0; a < 2; ++a)
#pragma unroll
        for (int b = 0; b < 2; ++b)
#pragma unroll
            for (int m = 0; m < 4; ++m)
#pragma unroll
                for (int n = 0; n < 2; ++n) acc[a][b][m][n] = (f32x4){0.f, 0.f, 0.f, 0.f};
    bf16x8 At[4][2], B0[2][2], B1[2][2];
    const char* cA = (const char*)g.A + (size_t)cur.pm * tstep; const char* cB = (const char*)g.Bt + (size_t)cur.pn * tstep;
    S.a_ready(cur);
    if constexpr (SP2) {
        PG8_STAGE(PG8_SB(0, 0), cB, voffB); PG8_STAGE(PG8_SB(0, 1), cB + hstep, voffB); PG8_STAGE(PG8_SA(0, 0), cA, voffA); PG8_STAGE(PG8_SA(0, 1), cA + hstep, voffA);
        if (wr == 1) PG8_BAR;
        PG8_WAIT_V(2); PG8_BAR;
        PG8_STAGE(PG8_SB(1, 0), cB + kstep, voffB); PG8_STAGE(PG8_SA(1, 0), cA + kstep, voffA); PG8_STAGE(PG8_SB(1, 1), cB + hstep + kstep, voffB);
        PG8_WAIT_V(6); PG8_BAR;
    } else {
        PG8_STAGE(PG8_SB(0, 0), cB, voffB); PG8_STAGE(PG8_SA(0, 0), cA, voffA); PG8_STAGE(PG8_SB(0, 1), cB + hstep, voffB); PG8_STAGE(PG8_SA(0, 1), cA + hstep, voffA);
        if (wr == 1) PG8_BAR;
        PG8_WAIT_V(4); PG8_BAR;
        PG8_STAGE(PG8_SB(1, 0), cB + kstep, voffB); PG8_STAGE(PG8_SA(1, 0), cA + kstep, voffA); PG8_STAGE(PG8_SB(1, 1), cB + hstep + kstep, voffB);
        PG8_WAIT_V(6); PG8_BAR;
    }
    for (;;) {
        const bool has_next = S.next(ui + 1, nxt);
        const char* nA = has_next ? (const char*)g.A + (size_t)nxt.pm * tstep : cA; const char* nB = has_next ? (const char*)g.Bt + (size_t)nxt.pn * tstep : cB;
        for (int t = 0; t < nt; t += 2) {
            const bool last = (t == nt - 2);
            const char* a1 = cA + (size_t)(t + 1) * kstep;
            const char* a2 = last ? nA : cA + (size_t)(t + 2) * kstep; const char* b2 = last ? nB : cB + (size_t)(t + 2) * kstep;
            const char* a3 = a2 + kstep; const char* b3 = b2 + kstep;
            if (last && has_next) S.a_ready(nxt);
            if constexpr (SP2) {
            PG8_LDB(B0, 0, 0); PG8_LDB(B1, 0, 1); PG8_SCHED; PG8_LDA(At, 0, 0); PG8_STAGE(PG8_SA(1, 1), a1 + hstep, voffA);
            PG8_WAIT_V(8); PG8_WAIT_L(0); PG8_BAR; PG8_MMA(0, 0, At, B0); PG8_MMA(0, 1, At, B1); PG8_BAR; PG8_SCHED;
            PG8_LDA(At, 0, 1); PG8_STAGE(PG8_SB(0, 0), b2, voffB); PG8_STAGE(PG8_SB(0, 1), b2 + hstep, voffB); PG8_STAGE(PG8_SA(0, 0), a2, voffA);
            PG8_WAIT_V(8); PG8_WAIT_L(0); PG8_BAR; PG8_MMA(1, 0, At, B0); PG8_MMA(1, 1, At, B1); PG8_BAR; PG8_SCHED;
            PG8_LDB(B0, 1, 0); PG8_LDB(B1, 1, 1); PG8_SCHED; PG8_LDA(At, 1, 0); PG8_STAGE(PG8_SA(0, 1), a2 + hstep, voffA);
            PG8_WAIT_V(8); PG8_WAIT_L(0); PG8_BAR; PG8_MMA(0, 0, At, B0); PG8_MMA(0, 1, At, B1); PG8_BAR; PG8_SCHED;
            PG8_LDA(At, 1, 1); PG8_STAGE(PG8_SB(1, 0), b3, voffB); PG8_STAGE(PG8_SB(1, 1), b3 + hstep, voffB); PG8_STAGE(PG8_SA(1, 0), a3, voffA);
            PG8_WAIT_V(8); PG8_WAIT_L(0); PG8_BAR; PG8_MMA(1, 0, At, B0); PG8_MMA(1, 1, At, B1); PG8_BAR; PG8_SCHED;
            } else {
            PG8_LDB(B0, 0, 0); PG8_SCHED; PG8_LDA(At, 0, 0); PG8_STAGE(PG8_SA(1, 1), a1 + hstep, voffA);
            PG8_WAIT_L(8); PG8_BAR; PG8_WAIT_L(0); PG8_MMA(0, 0, At, B0); PG8_BAR; PG8_SCHED;
            PG8_LDB(B1, 0, 1); PG8_STAGE(PG8_SB(0, 0), b2, voffB);
            PG8_BAR; PG8_WAIT_L(0); PG8_MMA(0, 1, At, B1); PG8_BAR;
            PG8_LDA(At, 0, 1); PG8_STAGE(PG8_SA(0, 0), a2, voffA);
            PG8_BAR; PG8_WAIT_L(0); PG8_MMA(1, 0, At, B0); PG8_BAR; PG8_SCHED;
            PG8_STAGE(PG8_SB(0, 1), b2 + hstep, voffB);
            PG8_WAIT_V(6); PG8_BAR; PG8_MMA(1, 1, At, B1); PG8_BAR;
            PG8_LDB(B0, 1, 0); PG8_SCHED; PG8_LDA(At, 1, 0); PG8_STAGE(PG8_SA(0, 1), a2 + hstep, voffA);
            PG8_WAIT_L(8); PG8_BAR; PG8_WAIT_L(0); PG8_MMA(0, 0, At, B0); PG8_BAR; PG8_SCHED;
            PG8_LDB(B1, 1, 1); PG8_STAGE(PG8_SB(1, 0), b3, voffB);
            PG8_BAR; PG8_WAIT_L(0); PG8_MMA(0, 1, At, B1); PG8_BAR;
            PG8_LDA(At, 1, 1); PG8_STAGE(PG8_SA(1, 0), a3, voffA);
            PG8_BAR; PG8_WAIT_L(0); PG8_MMA(1, 0, At, B0); PG8_BAR; PG8_SCHED;
            PG8_STAGE(PG8_SB(1, 1), b3 + hstep, voffB);
            PG8_WAIT_V(6); PG8_BAR; PG8_MMA(1, 1, At, B1); PG8_BAR;
            }
        }
        if constexpr (ALIGN_EPI) { if (wr == 0) PG8_BAR; }
        if constexpr (!Epi::AFTER_DRAIN) { E(acc, cur, wr, wc, fr, fq); S.done(cur); }
        if (!has_next) break;
#pragma unroll
        for (int a = 0; a < 2; ++a)
#pragma unroll
            for (int b = 0; b < 2; ++b)
#pragma unroll
                for (int m = 0; m < 4; ++m)
#pragma unroll
                    for (int n = 0; n < 2; ++n) acc[a][b][m][n] = (f32x4){0.f, 0.f, 0.f, 0.f};
        cur = nxt; cA = nA; cB = nB; ++ui;
        if constexpr (ALIGN_EPI) { if (wr == 1) PG8_BAR; }
    }
    PG8_WAIT_V(0);
    if constexpr (!ALIGN_EPI) { if (wr == 0) PG8_BAR; }
    PG8_BAR;
    if constexpr (Epi::AFTER_DRAIN) { E.fused(acc, cur, wr, wc, fr, fq, lds, wid, lane); S.done(cur); }
#undef PG8_SA
#undef PG8_SB
#undef PG8_STAGE
#undef PG8_LDA
#undef PG8_LDB
#undef PG8_MMA
#undef PG8_WAIT_V
#undef PG8_WAIT_L
#undef PG8_BAR
#undef PG8_SCHED
}
}

constexpr int D_MODEL = 1024, BATCH = 16, SEQ = 2048, M_TOK = BATCH * SEQ;
constexpr int MEM_LEN = 256, M_MEM = BATCH * MEM_LEN;
constexpr int D_FF = 2816, MIX_IN = 3360, LDU = 3584, RW_OFF = 1536, RWKV_IN = 1824;
constexpr int MEM_W = 512;
constexpr float NORM_EPS = 1e-6f, LNX_EPS = 64e-5f;
constexpr int NWAVES = 8, NTHREADS = 512;
constexpr int LDS_BYTES = 147456;
enum { I_X = 0, I_MEM, I_F1PRE, I_F1POST, I_F1WIN, I_F1WOUT, I_MIXPRE, I_MIXPOST, I_MIXWIN, I_MU, I_W0, I_W2, I_A0, I_A2, I_G2, I_KK, I_KA, I_RK, I_LNG, I_LNB,
       I_SBG, I_MIXWOUT, I_MEMPRE, I_MEMPOST, I_MEMKVG, I_WQ, I_WKV, I_WO, I_F2PRE, I_F2POST, I_F2WIN, I_F2WOUT, N_IN };
constexpr size_t MiB = 1u << 20;
constexpr size_t WS_W1IN = 2 * MiB, WS_W1OUT = 13 * MiB, WS_WMIXIN = 19 * MiB, WS_WMIXOUT = 26 * MiB, WS_WQ = 28 * MiB, WS_WKV = 29 * MiB, WS_WO = 31 * MiB,
                 WS_W2IN = 32 * MiB, WS_W2OUT = 43 * MiB, WS_LW2 = 49 * MiB, WS_LA2 = WS_LW2 + 65536, WS_LG2 = WS_LA2 + 65536,
                 WS_MEMN = 56 * MiB, WS_KVM = 64 * MiB, WS_XN = 72 * MiB, WS_Y = 136 * MiB, WS_HU = 200 * MiB, WS_HB = 424 * MiB, WS_END = 488 * MiB;
constexpr size_t WS_QM = WS_HU, WS_OM = WS_HU + 32 * MiB;

#define LAS __attribute__((address_space(3)))
typedef unsigned short bf16;
typedef short bf16x8 __attribute__((ext_vector_type(8)));
typedef short s16x4 __attribute__((ext_vector_type(4)));
typedef float f32x4 __attribute__((ext_vector_type(4)));
typedef float f32x2 __attribute__((ext_vector_type(2)));
typedef float f32x16 __attribute__((ext_vector_type(16)));
typedef unsigned u32x4 __attribute__((ext_vector_type(4)));
typedef unsigned u32x2 __attribute__((ext_vector_type(2)));

__device__ __forceinline__ float bflo(unsigned u) { return __uint_as_float(u << 16); }
__device__ __forceinline__ float bfhi(unsigned u) { return __uint_as_float(u & 0xffff0000u); }
__device__ __forceinline__ unsigned pk2(float lo, float hi) { return pg8::cvt_pk_bf16(lo, hi); }
template <int CTRL> __device__ __forceinline__ float dppf(float x) { return __builtin_bit_cast(float, __builtin_amdgcn_mov_dpp(__builtin_bit_cast(int, x), CTRL, 0xf, 0xf, true)); }
__device__ __forceinline__ float red16(float x) { x += dppf<0xB1>(x); x += dppf<0x4E>(x); x += dppf<0x141>(x); x += dppf<0x140>(x); return x; }
__device__ __forceinline__ float half_sum(float x) { auto t = __builtin_amdgcn_permlane32_swap(__float_as_uint(x), __float_as_uint(x), false, false); return __uint_as_float(t[0]) + __uint_as_float(t[1]); }
__device__ __forceinline__ float half_max(float x) { auto t = __builtin_amdgcn_permlane32_swap(__float_as_uint(x), __float_as_uint(x), false, false); return fmaxf(__uint_as_float(t[0]), __uint_as_float(t[1])); }
__device__ __forceinline__ float half_other(float x, int hi) { auto t = __builtin_amdgcn_permlane32_swap(__float_as_uint(x), __float_as_uint(x), false, false); return hi ? __uint_as_float(t[0]) : __uint_as_float(t[1]); }
__device__ __forceinline__ float wave_sum(float v) {
    v = red16(v);
    auto s = __builtin_amdgcn_permlane16_swap(__float_as_uint(v), __float_as_uint(v), false, false);
    v = __uint_as_float(s[0]) + __uint_as_float(s[1]);
    return half_sum(v);
}
#define LDS_BARRIER() do { asm volatile("s_waitcnt lgkmcnt(0)" ::: "memory"); __builtin_amdgcn_s_barrier(); asm volatile("" ::: "memory"); } while (0)
#define MFMA32(a, b, c) __builtin_amdgcn_mfma_f32_32x32x16_bf16((a), (b), (c), 0, 0, 0)

struct Args { const float* in[N_IN]; float* out; unsigned char* ws; int ph_lo, ph_hi; };

__device__ __forceinline__ void transpose_item(const float* W, int K, int N, bf16* WT, int ldk, int k0, int n0, int drow0, LAS float* scr, int lane) {
    float tv[32];
#pragma unroll
    for (int i = 0; i < 32; ++i) { const int k = k0 + 2 * i + (lane >> 5); tv[i] = (k < K) ? W[(size_t)k * N + n0 + (lane & 31)] : 0.f; }
#pragma unroll
    for (int i = 0; i < 32; ++i) scr[(2 * i + (lane >> 5)) * 33 + (lane & 31)] = tv[i];
    asm volatile("s_waitcnt lgkmcnt(0)" ::: "memory");
    const int c = lane & 7;
#pragma unroll
    for (int j = 0; j < 4; ++j) { const int n = (lane >> 3) + 8 * j; const LAS float* s = scr + (8 * c) * 33 + n;
        u32x4 o; o.x = pk2(s[0 * 33], s[1 * 33]); o.y = pk2(s[2 * 33], s[3 * 33]); o.z = pk2(s[4 * 33], s[5 * 33]); o.w = pk2(s[6 * 33], s[7 * 33]);
        if (k0 + 8 * c + 8 <= ldk) *(u32x4*)(WT + (size_t)(drow0 + n) * ldk + k0 + 8 * c) = o; }
    asm volatile("s_waitcnt lgkmcnt(0)" ::: "memory");
}
__device__ __forceinline__ void transpose_matrix_item(const float* W, int K, int N, bf16* WT, int ldk, int mode, int item, LAS float* scr, int lane) {
    const int nblk = N / 32, kb = item / nblk, nb = item % nblk, n0 = 32 * nb;
    int drow0 = n0;
    if (mode == 1) { drow0 = (n0 < D_FF) ? (n0 / 128) * 256 + (n0 % 128) : ((n0 - D_FF) / 128) * 256 + 128 + ((n0 - D_FF) % 128); }
    transpose_item(W, K, N, WT, ldk, 64 * kb, n0, drow0, scr, lane);
}
__device__ __forceinline__ void rms_rows2_to_bf16(const float* xrow, const float* g, bf16* orow, int lane) {
    const f32x4* gr = (const f32x4*)g + lane;
    f32x4 v[2][4]; float s[2] = {0.f, 0.f};
#pragma unroll
    for (int q = 0; q < 2; ++q) { const f32x4* xr = (const f32x4*)(xrow + (size_t)q * D_MODEL) + lane;
#pragma unroll
        for (int j = 0; j < 4; ++j) v[q][j] = xr[64 * j]; }
#pragma unroll
    for (int q = 0; q < 2; ++q)
#pragma unroll
        for (int j = 0; j < 4; ++j) s[q] += (v[q][j].x * v[q][j].x + v[q][j].y * v[q][j].y) + (v[q][j].z * v[q][j].z + v[q][j].w * v[q][j].w);
#pragma unroll
    for (int q = 0; q < 2; ++q) {
        const float rs = rsqrtf(wave_sum(s[q]) * (1.f / D_MODEL) + NORM_EPS);
        u32x2* o8 = (u32x2*)(orow + (size_t)q * D_MODEL) + lane;
#pragma unroll
        for (int j = 0; j < 4; ++j) { const f32x4 gg = gr[64 * j]; u32x2 o; o.x = pk2(v[q][j].x * rs * gg.x, v[q][j].y * rs * gg.y); o.y = pk2(v[q][j].z * rs * gg.z, v[q][j].w * rs * gg.w); o8[64 * j] = o; }
    }
}
template <int PART>
__device__ __forceinline__ void prologue(const Args& a, LAS unsigned char* lds, int gw, int NGW, int wave, int lane) {
    LAS float* scr = (LAS float*)(lds + wave * 16384);
    unsigned char* ws = a.ws;
    constexpr int I_FIN = (D_MODEL / 64) * (2 * D_FF / 32), I_FOUT = (D_FF / 64) * (D_MODEL / 32), I_MIN = (D_MODEL / 64) * (MIX_IN / 32), I_SQ = (D_MODEL / 64) * (D_MODEL / 32),
                  I_Q = (D_MODEL / 64) * (MEM_W / 32), I_O = (MEM_W / 64) * (D_MODEL / 32), I_L64 = 16, I_L160 = 48;
    if (PART == 0) {
        constexpr int NITEMS = I_FIN + I_FOUT + I_MIN + I_SQ + 2 * I_L64 + I_L160;
        for (int it = gw; it < NITEMS; it += NGW) {
            int r = it;
            if (r < I_FIN) { transpose_matrix_item(a.in[I_F1WIN], D_MODEL, 2 * D_FF, (bf16*)(ws + WS_W1IN), D_MODEL, 1, r, scr, lane); continue; } r -= I_FIN;
            if (r < I_FOUT) { transpose_matrix_item(a.in[I_F1WOUT], D_FF, D_MODEL, (bf16*)(ws + WS_W1OUT), D_FF, 0, r, scr, lane); continue; } r -= I_FOUT;
            if (r < I_MIN) { transpose_matrix_item(a.in[I_MIXWIN], D_MODEL, MIX_IN, (bf16*)(ws + WS_WMIXIN), D_MODEL, 0, r, scr, lane); continue; } r -= I_MIN;
            if (r < I_SQ) { transpose_matrix_item(a.in[I_WKV], D_MODEL, D_MODEL, (bf16*)(ws + WS_WKV), D_MODEL, 0, r, scr, lane); continue; } r -= I_SQ;
            if (r < I_L64) { transpose_matrix_item(a.in[I_W2], 64, 512, (bf16*)(ws + WS_LW2), 64, 0, r, scr, lane); continue; } r -= I_L64;
            if (r < I_L64) { transpose_matrix_item(a.in[I_A2], 64, 512, (bf16*)(ws + WS_LA2), 64, 0, r, scr, lane); continue; } r -= I_L64;
            transpose_matrix_item(a.in[I_G2], 160, 512, (bf16*)(ws + WS_LG2), 160, 0, r, scr, lane);
        }
        { u32x4* z = (u32x4*)((bf16*)(ws + WS_WMIXIN) + (size_t)MIX_IN * D_MODEL); const int n16 = (LDU - MIX_IN) * D_MODEL * 2 / 16;
          for (int i = gw * 64 + lane; i < n16; i += NGW * 64) z[i] = (u32x4){0u, 0u, 0u, 0u}; }
        for (int m = 2 * gw; m < M_TOK; m += 2 * NGW) rms_rows2_to_bf16(a.in[I_X] + (size_t)m * D_MODEL, a.in[I_F1PRE], (bf16*)(ws + WS_XN) + (size_t)m * D_MODEL, lane);
        for (int m = 2 * gw; m < M_MEM; m += 2 * NGW) rms_rows2_to_bf16(a.in[I_MEM] + (size_t)m * D_MODEL, a.in[I_MEMKVG], (bf16*)(ws + WS_MEMN) + (size_t)m * D_MODEL, lane);
    } else {
        constexpr int NITEMS = I_FIN + I_FOUT + I_SQ + I_Q + I_O;
        for (int it = gw; it < NITEMS; it += NGW) {
            int r = it;
            if (r < I_SQ) { transpose_matrix_item(a.in[I_MIXWOUT], D_MODEL, D_MODEL, (bf16*)(ws + WS_WMIXOUT), D_MODEL, 0, r, scr, lane); continue; } r -= I_SQ;
            if (r < I_Q) { transpose_matrix_item(a.in[I_WQ], D_MODEL, MEM_W, (bf16*)(ws + WS_WQ), D_MODEL, 0, r, scr, lane); continue; } r -= I_Q;
            if (r < I_O) { transpose_matrix_item(a.in[I_WO], MEM_W, D_MODEL, (bf16*)(ws + WS_WO), MEM_W, 0, r, scr, lane); continue; } r -= I_O;
            if (r < I_FIN) { transpose_matrix_item(a.in[I_F2WIN], D_MODEL, 2 * D_FF, (bf16*)(ws + WS_W2IN), D_MODEL, 1, r, scr, lane); continue; } r -= I_FIN;
            transpose_matrix_item(a.in[I_F2WOUT], D_FF, D_MODEL, (bf16*)(ws + WS_W2OUT), D_FF, 0, r, scr, lane);
        }
    }
}
template <bool HIN_BF, bool HOUT_BF>
__device__ __forceinline__ void norm_pass(const bf16* Y, const void* hin_, void* hout_, float coef, const float* gpost, const float* gpre, bf16* XN, int gw, int NGW, int lane) {
    f32x4 gp[4], gq[4];
#pragma unroll
    for (int j = 0; j < 4; ++j) { gp[j] = ((const f32x4*)gpost + lane)[64 * j]; gq[j] = gpre ? ((const f32x4*)gpre + lane)[64 * j] : (f32x4){0.f, 0.f, 0.f, 0.f}; }
    u32x2 ry[2][4]; u32x2 rhb[2][4]; f32x4 rhf[2][4];
#define NP_LOAD(r0) do { _Pragma("unroll") for (int q = 0; q < 2; ++q) { \
        const u32x2* yr = (const u32x2*)(Y + (size_t)((r0) + q) * D_MODEL) + lane; \
        _Pragma("unroll") for (int j = 0; j < 4; ++j) ry[q][j] = yr[64 * j]; \
        if (HIN_BF) { const u32x2* hr = (const u32x2*)((const bf16*)hin_ + (size_t)((r0) + q) * D_MODEL) + lane; _Pragma("unroll") for (int j = 0; j < 4; ++j) rhb[q][j] = hr[64 * j]; } \
        else { const f32x4* hr = (const f32x4*)((const float*)hin_ + (size_t)((r0) + q) * D_MODEL) + lane; _Pragma("unroll") for (int j = 0; j < 4; ++j) rhf[q][j] = hr[64 * j]; } } } while (0)
    int row0 = 2 * gw;
    if (row0 < M_TOK) NP_LOAD(row0);
    for (; row0 < M_TOK; row0 += 2 * NGW) {
        f32x4 y[2][4], h[2][4]; float s[2] = {0.f, 0.f};
#pragma unroll
        for (int q = 0; q < 2; ++q)
#pragma unroll
            for (int j = 0; j < 4; ++j) { const u32x2 t = ry[q][j]; y[q][j] = (f32x4){bflo(t.x), bfhi(t.x), bflo(t.y), bfhi(t.y)};
                if (HIN_BF) { const u32x2 u = rhb[q][j]; h[q][j] = (f32x4){bflo(u.x), bfhi(u.x), bflo(u.y), bfhi(u.y)}; } else h[q][j] = rhf[q][j]; }
        if (row0 + 2 * NGW < M_TOK) NP_LOAD(row0 + 2 * NGW);
#pragma unroll
        for (int q = 0; q < 2; ++q)
#pragma unroll
            for (int j = 0; j < 4; ++j) s[q] += (y[q][j].x * y[q][j].x + y[q][j].y * y[q][j].y) + (y[q][j].z * y[q][j].z + y[q][j].w * y[q][j].w);
#pragma unroll
        for (int q = 0; q < 2; ++q) {
            const float rs = rsqrtf(wave_sum(s[q]) * (1.f / D_MODEL) + NORM_EPS) * coef;
            float s2 = 0.f;
#pragma unroll
            for (int j = 0; j < 4; ++j) { h[q][j] = h[q][j] + y[q][j] * rs * gp[j];
                s2 += (h[q][j].x * h[q][j].x + h[q][j].y * h[q][j].y) + (h[q][j].z * h[q][j].z + h[q][j].w * h[q][j].w); }
            if (HOUT_BF) { u32x2* orow = (u32x2*)((bf16*)hout_ + (size_t)(row0 + q) * D_MODEL) + lane;
#pragma unroll
                for (int j = 0; j < 4; ++j) { u32x2 o; o.x = pk2(h[q][j].x, h[q][j].y); o.y = pk2(h[q][j].z, h[q][j].w); orow[64 * j] = o; } }
            else { f32x4* orow = (f32x4*)((float*)hout_ + (size_t)(row0 + q) * D_MODEL) + lane;
#pragma unroll
                for (int j = 0; j < 4; ++j) orow[64 * j] = h[q][j]; }
            if (gpre) {
                const float rs2 = rsqrtf(wave_sum(s2) * (1.f / D_MODEL) + NORM_EPS);
                u32x2* o8 = (u32x2*)(XN + (size_t)(row0 + q) * D_MODEL) + lane;
#pragma unroll
                for (int j = 0; j < 4; ++j) { const f32x4 g = gq[j]; u32x2 o; o.x = pk2(h[q][j].x * rs2 * g.x, h[q][j].y * rs2 * g.y); o.y = pk2(h[q][j].z * rs2 * g.z, h[q][j].w * rs2 * g.w); o8[64 * j] = o; }
            }
        }
    }
#undef NP_LOAD
}
constexpr int SB_KP = 72, SB_VP = 72;
typedef short v4i16_t __attribute__((ext_vector_type(4)));
__device__ __forceinline__ s16x4 lds_tr16(const LAS bf16* p) { return __builtin_bit_cast(s16x4, __builtin_amdgcn_ds_read_tr16_b64_v4i16((LAS v4i16_t*)p)); }
__device__ __forceinline__ void sb_unit(LAS unsigned char* lds, const bf16* U, bf16* MIX, const float* sbg, int b, int h, int qb, const int tid) {
    const int wave = tid >> 6, lane = tid & 63, j = lane & 31, hi = lane >> 5;
    LAS bf16* Ks = (LAS bf16*)lds;
    LAS bf16* Vt = (LAS bf16*)(lds + 64 * SB_KP * 2);
    const int qw = 256 * qb + 32 * wave;
    const size_t rowbase = (size_t)b * SEQ;
    bf16x8 qf[4];
    { const bf16* qp = U + (rowbase + qw + j) * LDU + h * 64 + 8 * hi;
#pragma unroll
      for (int ks = 0; ks < 4; ++ks) { const u32x4 raw = *(const u32x4*)(qp + 16 * ks); u32x4 sc;
          const float qs = 0.125f * 1.4426950408889634f;
          sc.x = pk2(bflo(raw.x) * qs, bfhi(raw.x) * qs); sc.y = pk2(bflo(raw.y) * qs, bfhi(raw.y) * qs);
          sc.z = pk2(bflo(raw.z) * qs, bfhi(raw.z) * qs); sc.w = pk2(bflo(raw.w) * qs, bfhi(raw.w) * qs);
          qf[ks] = __builtin_bit_cast(bf16x8, sc); } }
    f32x16 o0, o1;
#pragma unroll
    for (int r = 0; r < 16; ++r) { o0[r] = 0.f; o1[r] = 0.f; }
    float carry = 1.f;
    const int st_key = tid >> 3, st_dg = tid & 7;
    const bf16* kp0 = U + (rowbase + st_key) * LDU + 512 + h * 64 + 8 * st_dg;
    u32x4 kv = *(const u32x4*)(kp0 + (size_t)(64 * (4 * qb + 3)) * LDU), vv = *(const u32x4*)(kp0 + (size_t)(64 * (4 * qb + 3)) * LDU + 512);
    for (int jt = 4 * qb + 3; jt >= 0; --jt) {
        LDS_BARRIER();
        { *(LAS u32x4*)(Ks + st_key * SB_KP + 8 * st_dg) = kv;
          *(LAS u32x4*)(Vt + st_key * SB_VP + 8 * st_dg) = vv; }
        LDS_BARRIER();
        if (jt > 0) { kv = *(const u32x4*)(kp0 + (size_t)(64 * (jt - 1)) * LDU); vv = *(const u32x4*)(kp0 + (size_t)(64 * (jt - 1)) * LDU + 512); }
#pragma unroll 1
        for (int sub = 1; sub >= 0; --sub) {
            const int kbase = 64 * jt + 32 * sub;
            if (kbase > qw) continue;
            f32x16 acc;
#pragma unroll
            for (int r = 0; r < 16; ++r) acc[r] = 0.f;
#pragma unroll
            for (int ks = 0; ks < 4; ++ks) { const bf16x8 a = *(const LAS bf16x8*)(Ks + (32 * sub + j) * SB_KP + 16 * ks + 8 * hi); acc = MFMA32(a, qf[ks], acc); }
            const bool diag = (kbase == qw);
            float e[16], incl[16];
#pragma unroll
            for (int r = 0; r < 16; ++r) { const int i = 8 * (r >> 2) + 4 * hi + (r & 3); const float z = fminf(acc[r], 115.f);
                float ev = __builtin_amdgcn_exp2f(z); float dv = __builtin_amdgcn_rcpf(1.f + ev);
                if (diag && i >= j) { ev = 0.f; dv = 1.f; }
                e[r] = ev; incl[r] = dv; }
            float GP[4], GPo[4];
#pragma unroll
            for (int g = 0; g < 4; ++g) { incl[4 * g + 2] *= incl[4 * g + 3]; incl[4 * g + 1] *= incl[4 * g + 2]; incl[4 * g] *= incl[4 * g + 1]; GP[g] = incl[4 * g]; GPo[g] = half_other(GP[g], hi); }
            float ma[4], oi[4], base[4];
            ma[3] = 1.f; ma[2] = GP[3]; ma[1] = GP[2] * ma[2]; ma[0] = GP[1] * ma[1];
            oi[3] = GPo[3]; oi[2] = GPo[2] * oi[3]; oi[1] = GPo[1] * oi[2]; oi[0] = GPo[0] * oi[1];
            base[0] = carry * ma[0] * (hi ? oi[1] : oi[0]); base[1] = carry * ma[1] * (hi ? oi[2] : oi[1]);
            base[2] = carry * ma[2] * (hi ? oi[3] : oi[2]); base[3] = carry * ma[3] * (hi ? 1.f : oi[3]);
            carry = carry * ((GP[0] * ma[0]) * oi[0]);
            u32x4 p0, p1;
            p0.x = pk2(e[0] * incl[0] * base[0], e[1] * incl[1] * base[0]); p0.y = pk2(e[2] * incl[2] * base[0], e[3] * incl[3] * base[0]);
            p0.z = pk2(e[4] * incl[4] * base[1], e[5] * incl[5] * base[1]); p0.w = pk2(e[6] * incl[6] * base[1], e[7] * incl[7] * base[1]);
            p1.x = pk2(e[8] * incl[8] * base[2], e[9] * incl[9] * base[2]); p1.y = pk2(e[10] * incl[10] * base[2], e[11] * incl[11] * base[2]);
            p1.z = pk2(e[12] * incl[12] * base[3], e[13] * incl[13] * base[3]); p1.w = pk2(e[14] * incl[14] * base[3], e[15] * incl[15] * base[3]);
            const bf16x8 pa0 = __builtin_bit_cast(bf16x8, p0), pa1 = __builtin_bit_cast(bf16x8, p1);
#pragma unroll
            for (int s = 0; s < 2; ++s) {
                const bf16x8 pb = s ? pa1 : pa0;
                const LAS bf16* vp = Vt + (32 * sub + 16 * s + 4 * hi + ((lane & 15) >> 2)) * SB_VP + 16 * ((lane >> 4) & 1) + 4 * (lane & 3);
                { const s16x4 lo = lds_tr16(vp), hh = lds_tr16(vp + 8 * SB_VP); const bf16x8 va = __builtin_shufflevector(lo, hh, 0, 1, 2, 3, 4, 5, 6, 7); o0 = MFMA32(va, pb, o0); }
                { const s16x4 lo = lds_tr16(vp + 32), hh = lds_tr16(vp + 8 * SB_VP + 32); const bf16x8 va = __builtin_shufflevector(lo, hh, 0, 1, 2, 3, 4, 5, 6, 7); o1 = MFMA32(va, pb, o1); }
            }
        }
    }
    float ss = 0.f;
#pragma unroll
    for (int r = 0; r < 16; ++r) ss += o0[r] * o0[r] + o1[r] * o1[r];
    ss = half_sum(ss);
    const float rs = rsqrtf(ss * (1.f / 64.f) + NORM_EPS);
    bf16* op = MIX + (rowbase + qw + j) * D_MODEL + h * 64 + 4 * hi;
    const float* gp = sbg + h * 64 + 4 * hi;
#pragma unroll
    for (int g = 0; g < 4; ++g) {
        const f32x4 g0 = *(const f32x4*)(gp + 8 * g), g1 = *(const f32x4*)(gp + 32 + 8 * g);
        u32x2 w0, w1;
        w0.x = pk2(o0[4 * g] * rs * g0.x, o0[4 * g + 1] * rs * g0.y); w0.y = pk2(o0[4 * g + 2] * rs * g0.z, o0[4 * g + 3] * rs * g0.w);
        w1.x = pk2(o1[4 * g] * rs * g1.x, o1[4 * g + 1] * rs * g1.y); w1.y = pk2(o1[4 * g + 2] * rs * g1.z, o1[4 * g + 3] * rs * g1.w);
        *(u32x2*)(op + 8 * g) = w0; *(u32x2*)(op + 32 + 8 * g) = w1;
    }
}

constexpr int XA_KP = 136, XA_VP = 136;
__device__ __forceinline__ void xatt_stage(LAS unsigned char* lds, const bf16* KVm, int b, int mh, const int tid) {
    LAS bf16* Ks = (LAS bf16*)lds;
    LAS bf16* Vt = (LAS bf16*)(lds + 256 * XA_KP * 2);
    const bf16* base = KVm + (size_t)b * MEM_LEN * D_MODEL + mh * 128;
    u32x4 kv[8];
#pragma unroll
    for (int i = 0; i < 8; ++i) { const int p = tid + 512 * i, key = p >> 4, dg = p & 15; kv[i] = *(const u32x4*)(base + (size_t)key * D_MODEL + 8 * dg); }
#pragma unroll
    for (int i = 0; i < 8; ++i) { const int p = tid + 512 * i, key = p >> 4, dg = p & 15; *(LAS u32x4*)(Ks + key * XA_KP + 8 * dg) = kv[i]; }
#pragma unroll
    for (int i = 0; i < 8; ++i) { const int p = tid + 512 * i, key = p >> 4, dg = p & 15; kv[i] = *(const u32x4*)(base + (size_t)key * D_MODEL + 512 + 8 * dg); }
#pragma unroll
    for (int i = 0; i < 8; ++i) { const int p = tid + 512 * i, key = p >> 4, dg = p & 15; *(LAS u32x4*)(Vt + key * XA_VP + 8 * dg) = kv[i]; }
}
__device__ __forceinline__ void xatt_unit(LAS unsigned char* lds, const bf16* Qm, bf16* Om, int b, int mh, int qb, const int tid) {
    const int wave = tid >> 6, lane = tid & 63, j = lane & 31, hi = lane >> 5;
    LAS bf16* Ks = (LAS bf16*)lds;
    LAS bf16* Vt = (LAS bf16*)(lds + 256 * XA_KP * 2);
    const int qw = 256 * qb + 32 * wave;
    const size_t qrow = (size_t)b * SEQ + qw + j;
    bf16x8 qf[8];
    { const bf16* qp = Qm + qrow * MEM_W + mh * 128 + 8 * hi;
#pragma unroll
      for (int ks = 0; ks < 8; ++ks) qf[ks] = *(const bf16x8*)(qp + 16 * ks); }
    f32x16 o[4];
#pragma unroll
    for (int t = 0; t < 4; ++t)
#pragma unroll
        for (int r = 0; r < 16; ++r) o[t][r] = 0.f;
    float mrun = -1e30f, lsum = 0.f;
    const float scale = 0.08838834764831845f;
#pragma unroll 1
    for (int sub = 0; sub < 8; ++sub) {
        f32x16 acc;
#pragma unroll
        for (int r = 0; r < 16; ++r) acc[r] = 0.f;
#pragma unroll
        for (int ks = 0; ks < 8; ++ks) { const bf16x8 a = *(const LAS bf16x8*)(Ks + (32 * sub + j) * XA_KP + 16 * ks + 8 * hi); acc = MFMA32(a, qf[ks], acc); }
        float mx = -1e30f;
#pragma unroll
        for (int r = 0; r < 16; ++r) { acc[r] *= scale; mx = fmaxf(mx, acc[r]); }
        mx = half_max(mx);
        const float mnew = fmaxf(mrun, mx), corr = __expf(mrun - mnew);
        mrun = mnew; lsum *= corr;
        float p[16];
#pragma unroll
        for (int r = 0; r < 16; ++r) { p[r] = __expf(acc[r] - mnew); lsum += p[r]; }
#pragma unroll
        for (int t = 0; t < 4; ++t)
#pragma unroll
            for (int r = 0; r < 16; ++r) o[t][r] *= corr;
        u32x4 p0, p1;
        p0.x = pk2(p[0], p[1]); p0.y = pk2(p[2], p[3]); p0.z = pk2(p[4], p[5]); p0.w = pk2(p[6], p[7]);
        p1.x = pk2(p[8], p[9]); p1.y = pk2(p[10], p[11]); p1.z = pk2(p[12], p[13]); p1.w = pk2(p[14], p[15]);
        const bf16x8 pa0 = __builtin_bit_cast(bf16x8, p0), pa1 = __builtin_bit_cast(bf16x8, p1);
#pragma unroll
        for (int s = 0; s < 2; ++s) {
            const bf16x8 pb = s ? pa1 : pa0;
#pragma unroll
            for (int t = 0; t < 4; ++t) {
                const LAS bf16* vp = Vt + (32 * sub + 16 * s + 4 * hi + ((lane & 15) >> 2)) * XA_VP + 32 * t + 16 * ((lane >> 4) & 1) + 4 * (lane & 3);
                const s16x4 lo = lds_tr16(vp), hh = lds_tr16(vp + 8 * XA_VP); const bf16x8 va = __builtin_shufflevector(lo, hh, 0, 1, 2, 3, 4, 5, 6, 7);
                o[t] = MFMA32(va, pb, o[t]);
            }
        }
    }
    lsum = half_sum(lsum);
    const float inv = 1.f / lsum;
    bf16* op = Om + qrow * MEM_W + mh * 128 + 4 * hi;
#pragma unroll
    for (int t = 0; t < 4; ++t)
#pragma unroll
        for (int g = 0; g < 4; ++g) { u32x2 w; w.x = pk2(o[t][4 * g] * inv, o[t][4 * g + 1] * inv); w.y = pk2(o[t][4 * g + 2] * inv, o[t][4 * g + 3] * inv); *(u32x2*)(op + 32 * t + 8 * g) = w; }
}

constexpr int RW_P = 68;
constexpr int RW_ARR = 32 * RW_P * 4;
constexpr int RW_XWP = 72, RW_XGP = 168;
__device__ __forceinline__ void rw_lerp8(const u32x4 cu, const u32x4 pr, const LAS float* mu, float (&v)[8]) {
    const f32x4 m0 = *(const LAS f32x4*)mu, m1 = *(const LAS f32x4*)(mu + 4);
    float x, p;
    x = bflo(cu.x); p = bflo(pr.x); v[0] = x + (p - x) * m0.x;  x = bfhi(cu.x); p = bfhi(pr.x); v[1] = x + (p - x) * m0.y;
    x = bflo(cu.y); p = bflo(pr.y); v[2] = x + (p - x) * m0.z;  x = bfhi(cu.y); p = bfhi(pr.y); v[3] = x + (p - x) * m0.w;
    x = bflo(cu.z); p = bflo(pr.z); v[4] = x + (p - x) * m1.x;  x = bfhi(cu.z); p = bfhi(pr.z); v[5] = x + (p - x) * m1.y;
    x = bflo(cu.w); p = bflo(pr.w); v[6] = x + (p - x) * m1.z;  x = bfhi(cu.w); p = bfhi(pr.w); v[7] = x + (p - x) * m1.w;
}
__device__ __forceinline__ void rw_st_f32(LAS float* dst, const float (&v)[8]) { *(LAS f32x4*)dst = (f32x4){v[0], v[1], v[2], v[3]}; *(LAS f32x4*)(dst + 4) = (f32x4){v[4], v[5], v[6], v[7]}; }
__device__ __forceinline__ void rw_st_bf16(LAS bf16* dst, const float (&v)[8]) { u32x4 w; w.x = pk2(v[0], v[1]); w.y = pk2(v[2], v[3]); w.z = pk2(v[4], v[5]); w.w = pk2(v[6], v[7]); *(LAS u32x4*)dst = w; }
__device__ __forceinline__ void rwkv_head(LAS unsigned char* lds, const Args& a, const bf16* U, bf16* MIX, int b, int h, const int tid) {
    const int wave = __builtin_amdgcn_readfirstlane(tid >> 6), lane = tid & 63;
    LAS float* R = (LAS float*)(lds + 0 * RW_ARR); LAS float* Wd = (LAS float*)(lds + 1 * RW_ARR); LAS float* Kk = (LAS float*)(lds + 2 * RW_ARR); LAS float* Vv = (LAS float*)(lds + 3 * RW_ARR);
    LAS float* Aa = (LAS float*)(lds + 4 * RW_ARR); LAS float* Bb = (LAS float*)(lds + 5 * RW_ARR); LAS float* Gg = (LAS float*)(lds + 6 * RW_ARR); LAS float* Yy = (LAS float*)(lds + 7 * RW_ARR);
    LAS float* RK = (LAS float*)(lds + 8 * RW_ARR);
    LAS float* MU = (LAS float*)(lds + 8 * RW_ARR + 256);
    LAS bf16* XW = (LAS bf16*)(lds + 8 * RW_ARR + 256 + 2048); LAS bf16* XA = XW + 32 * RW_XWP; LAS bf16* XG = XA + 32 * RW_XWP;
    const int tok = tid >> 4, l16 = tid & 15, lo8 = (l16 < 8), l7 = l16 & 7;
    const int col0 = lo8 ? 64 * h + 8 * l7 : 512 + 64 * h + 8 * l7;
    const int col1 = lo8 ? 1024 + 64 * h + 8 * l7 : 1600 + 8 * l7;
    const int col2 = lo8 ? 1536 + 8 * l7 : 1664 + 8 * l7;
    const int col3 = 1728 + 8 * l16;
    __syncthreads();
    if (tid < 64) { const int i = tid >> 4, q = tid & 15; const bool q8 = q < 8; const int q7 = q & 7;
        const int cc = (i == 0) ? (q8 ? 64 * h + 8 * q7 : 512 + 64 * h + 8 * q7) : (i == 1) ? (q8 ? 1024 + 64 * h + 8 * q7 : 1600 + 8 * q7) : (i == 2) ? (q8 ? 1536 + 8 * q7 : 1664 + 8 * q7) : (q < 12 ? 1728 + 8 * q : 1728);
        const float* mu = a.in[I_MU] + cc;
#pragma unroll
        for (int e = 0; e < 8; ++e) MU[(i * 16 + q) * 8 + e] = mu[e]; }
    const int c4 = 4 * l16, gc = 64 * h + c4;
    const f32x4 kkw = *(const f32x4*)(a.in[I_KK] + gc), kaw = *(const f32x4*)(a.in[I_KA] + gc), rkw = *(const f32x4*)(a.in[I_RK] + gc);
    const f32x4 lg = *(const f32x4*)(a.in[I_LNG] + gc), lb = *(const f32x4*)(a.in[I_LNB] + gc);
    const int lkind = (wave < 4) ? (wave >> 1) : 2, lnt = wave & 1, lj = lane & 31, lhi = lane >> 5;
    const bool lactive = (wave < 4) || (wave >= 6);
    const int lnks = (lkind == 2) ? 10 : 4;
    const int lgcol = 64 * h + 32 * lnt + lj;
    bf16x8 wf[10];
    float lbias = 0.f;
    if (lactive) {
        const bf16* wb = (lkind == 0 ? (const bf16*)(a.ws + WS_LW2) + (size_t)lgcol * 64 : lkind == 1 ? (const bf16*)(a.ws + WS_LA2) + (size_t)lgcol * 64 : (const bf16*)(a.ws + WS_LG2) + (size_t)lgcol * 160) + 8 * lhi;
#pragma unroll
        for (int ks = 0; ks < 10; ++ks) if (ks < lnks) wf[ks] = *(const bf16x8*)(wb + 16 * ks);
        if (lkind == 0) lbias = a.in[I_W0][lgcol]; else if (lkind == 1) lbias = a.in[I_A0][lgcol];
    }
    const int srow = 8 * wave + 2 * (lane >> 4), kl = lane & 15;
    f32x4 pvv = {0.f, 0.f, 0.f, 0.f}, pgg = {0.f, 0.f, 0.f, 0.f}; float prk = 0.f;
    float S00 = 0.f, S01 = 0.f, S02 = 0.f, S03 = 0.f, S10 = 0.f, S11 = 0.f, S12 = 0.f, S13 = 0.f;
    const bf16* ubase = U + ((size_t)b * SEQ + tok) * LDU + RW_OFF;
    u32x4 cu0, cu1, cu2, cu3, pr0, pr1, pr2, pr3;
    const u32x4 z4 = (u32x4){0u, 0u, 0u, 0u};
    cu0 = *(const u32x4*)(ubase + col0); cu1 = *(const u32x4*)(ubase + col1); cu2 = *(const u32x4*)(ubase + col2); cu3 = (l16 < 12) ? *(const u32x4*)(ubase + col3) : z4;
    pr0 = z4; pr1 = z4; pr2 = z4; pr3 = z4;
    if (tok > 0) { pr0 = *(const u32x4*)(ubase - LDU + col0); pr1 = *(const u32x4*)(ubase - LDU + col1); pr2 = *(const u32x4*)(ubase - LDU + col2); if (l16 < 12) pr3 = *(const u32x4*)(ubase - LDU + col3); }
    __syncthreads();
    for (int c = 0; c < SEQ / 32; ++c) {
        const int t0 = 32 * c;
        {
            float v[8];
            rw_lerp8(cu0, pr0, MU + (0 * 16 + l16) * 8, v); rw_st_f32((lo8 ? R : Kk) + tok * RW_P + 8 * l7, v);
            rw_lerp8(cu1, pr1, MU + (1 * 16 + l16) * 8, v);
            if (lo8) rw_st_f32(Vv + tok * RW_P + 8 * l7, v); else rw_st_bf16(XA + tok * RW_XWP + 8 * l7, v);
            rw_lerp8(cu2, pr2, MU + (2 * 16 + l16) * 8, v);
            { const float s0 = lo8 ? -2.f : -1.f, s1 = lo8 ? 2.f : 1.f, s2 = lo8 ? -1.f : 0.f;
#pragma unroll
              for (int i = 0; i < 8; ++i) { const float xx = fminf(fmaxf(v[i], -30.f), 30.f); v[i] = fmaf(s1, __builtin_amdgcn_rcpf(1.f + __expf(s0 * xx)), s2); }
              rw_st_bf16((lo8 ? XW + tok * RW_XWP : XG + tok * RW_XGP) + 8 * l7, v); }
            if (l16 < 12) {
                rw_lerp8(cu3, pr3, MU + (3 * 16 + l16) * 8, v);
#pragma unroll
                for (int i = 0; i < 8; ++i) v[i] = __builtin_amdgcn_rcpf(1.f + __expf(-v[i]));
                rw_st_bf16(XG + tok * RW_XGP + 64 + 8 * l16, v); }
        }
        LDS_BARRIER();
        if (c + 1 < SEQ / 32) {
            const bf16* ub = ubase + (size_t)(t0 + 32) * LDU;
            cu0 = *(const u32x4*)(ub + col0); cu1 = *(const u32x4*)(ub + col1); cu2 = *(const u32x4*)(ub + col2); if (l16 < 12) cu3 = *(const u32x4*)(ub + col3);
            pr0 = *(const u32x4*)(ub - LDU + col0); pr1 = *(const u32x4*)(ub - LDU + col1); pr2 = *(const u32x4*)(ub - LDU + col2); if (l16 < 12) pr3 = *(const u32x4*)(ub - LDU + col3);
        }
        if (lactive) {
            const LAS bf16* xa = (lkind == 0 ? XW + lj * RW_XWP : lkind == 1 ? XA + lj * RW_XWP : XG + lj * RW_XGP) + 8 * lhi;
            f32x16 acc;
#pragma unroll
            for (int r = 0; r < 16; ++r) acc[r] = 0.f;
#pragma unroll
            for (int ks = 0; ks < 10; ++ks) if (ks < lnks) { const bf16x8 av = *(const LAS bf16x8*)(xa + 16 * ks); acc = MFMA32(av, wf[ks], acc); }
            const int col = 32 * lnt + lj;
            if (lkind == 0) {
#pragma unroll
                for (int r = 0; r < 16; ++r) { const int tk = 8 * (r >> 2) + 4 * lhi + (r & 3); const float x = lbias + acc[r];
                    Wd[tk * RW_P + col] = __expf(-0.6065306597126334f * __builtin_amdgcn_rcpf(1.f + __expf(-x))); }
            } else if (lkind == 1) {
#pragma unroll
                for (int r = 0; r < 16; ++r) { const int tk = 8 * (r >> 2) + 4 * lhi + (r & 3); Bb[tk * RW_P + col] = __builtin_amdgcn_rcpf(1.f + __expf(-(lbias + acc[r]))); }
            } else {
#pragma unroll
                for (int r = 0; r < 16; ++r) { const int tk = 8 * (r >> 2) + 4 * lhi + (r & 3); Gg[tk * RW_P + col] = acc[r]; }
            }
        }
        LDS_BARRIER();
        {
            if (c > 0) {
                f32x4 y; { const LAS float* yq = (const LAS float*)(lds + 94208) + (tok * 32 + 2 * l16) * 8; const f32x4 v0 = *(const LAS f32x4*)yq, v1 = *(const LAS f32x4*)(yq + 4), v2 = *(const LAS f32x4*)(yq + 8), v3 = *(const LAS f32x4*)(yq + 12);
                  y = (f32x4){(v0.x + v0.z) + (v1.x + v1.z), (v0.y + v0.w) + (v1.y + v1.w), (v2.x + v2.z) + (v3.x + v3.z), (v2.y + v2.w) + (v3.y + v3.w)}; }
                const float mean = red16((y.x + y.y) + (y.z + y.w)) * (1.f / 64.f);
                const f32x4 d = y - mean;
                const float var = red16((d.x * d.x + d.y * d.y) + (d.z * d.z + d.w * d.w)) * (1.f / 64.f);
                const float rs = rsqrtf(var + LNX_EPS);
                const f32x4 o = (d * rs * lg + lb + prk * pvv) * pgg;
                u32x2 w; w.x = pk2(o.x, o.y); w.y = pk2(o.z, o.w);
                *(u32x2*)(MIX + ((size_t)b * SEQ + t0 - 32 + tok) * D_MODEL + 512 + gc) = w;
            }
            const f32x4 kr = *(LAS f32x4*)(Kk + tok * RW_P + c4), al = *(LAS f32x4*)(Bb + tok * RW_P + c4), rr = *(LAS f32x4*)(R + tok * RW_P + c4);
            pvv = *(LAS f32x4*)(Vv + tok * RW_P + c4); pgg = *(LAS f32x4*)(Gg + tok * RW_P + c4);
            f32x4 kkv = kr * kkw;
            const float ssq = red16((kkv.x * kkv.x + kkv.y * kkv.y) + (kkv.z * kkv.z + kkv.w * kkv.w));
            const float inv = 1.f / fmaxf(sqrtf(ssq), 1e-12f);
            kkv = kkv * inv;
            const f32x4 km = kr * (1.f + (al - 1.f) * kaw);
            *(LAS f32x4*)(Aa + tok * RW_P + c4) = -kkv;
            *(LAS f32x4*)(Bb + tok * RW_P + c4) = kkv * al;
            *(LAS f32x4*)(Kk + tok * RW_P + c4) = km;
            const f32x4 pr = rr * km * rkw;
            prk = red16((pr.x + pr.y) + (pr.z + pr.w));
        }
        LDS_BARRIER();
        {
            const unsigned ak = (unsigned)(size_t)lds + 16u * kl, av = (unsigned)(size_t)lds + 3u * RW_ARR + 4u * srow;
            const unsigned yaddr = (unsigned)(size_t)(lds + 94208 + ((srow >> 1) * 4 + (kl >> 2)) * 8);
            const unsigned ystep = 1024u;
#define RW_LDS_STEP(tt) do { const unsigned _a = ak + (unsigned)((tt) * RW_P * 4), _v = av + (unsigned)((tt) * RW_P * 4); \
                asm volatile("ds_read_b128 %0, %1 offset:34816" : "=v"(na) : "v"(_a)); asm volatile("ds_read_b128 %0, %1 offset:8704" : "=v"(nw) : "v"(_a)); \
                asm volatile("ds_read_b128 %0, %1 offset:43520" : "=v"(nb) : "v"(_a)); asm volatile("ds_read_b128 %0, %1 offset:17408" : "=v"(nk) : "v"(_a)); \
                asm volatile("ds_read_b128 %0, %1" : "=v"(nr) : "v"(_a)); asm volatile("ds_read_b64 %0, %1" : "=v"(nv) : "v"(_v)); } while (0)
            f32x4 na, nw, nb, nk, nr; f32x2 nv;
            RW_LDS_STEP(0);
            asm volatile("s_waitcnt lgkmcnt(0)" : "+v"(na), "+v"(nw), "+v"(nb), "+v"(nk), "+v"(nr), "+v"(nv));
#pragma unroll 4
            for (int t = 0; t < 32; ++t) {
                const f32x4 a4 = na, w4 = nw, b4 = nb, k4 = nk, r4 = nr; const f32x2 v2 = nv;
                RW_LDS_STEP((t + 1) & 31);
                float sa0 = fmaf(S03, a4.w, fmaf(S02, a4.z, fmaf(S01, a4.y, S00 * a4.x)));
                float sa1 = fmaf(S13, a4.w, fmaf(S12, a4.z, fmaf(S11, a4.y, S10 * a4.x)));
                sa0 = red16(sa0); sa1 = red16(sa1);
                S00 = fmaf(v2.x, k4.x, fmaf(sa0, b4.x, S00 * w4.x)); S01 = fmaf(v2.x, k4.y, fmaf(sa0, b4.y, S01 * w4.y));
                S02 = fmaf(v2.x, k4.z, fmaf(sa0, b4.z, S02 * w4.z)); S03 = fmaf(v2.x, k4.w, fmaf(sa0, b4.w, S03 * w4.w));
                S10 = fmaf(v2.y, k4.x, fmaf(sa1, b4.x, S10 * w4.x)); S11 = fmaf(v2.y, k4.y, fmaf(sa1, b4.y, S11 * w4.y));
                S12 = fmaf(v2.y, k4.z, fmaf(sa1, b4.z, S12 * w4.z)); S13 = fmaf(v2.y, k4.w, fmaf(sa1, b4.w, S13 * w4.w));
                float y0 = fmaf(S03, r4.w, fmaf(S02, r4.z, fmaf(S01, r4.y, S00 * r4.x)));
                float y1 = fmaf(S13, r4.w, fmaf(S12, r4.z, fmaf(S11, r4.y, S10 * r4.x)));
                asm volatile("" : "+v"(y0), "+v"(y1));
                y0 += dppf<0xB1>(y0); y1 += dppf<0xB1>(y1); y0 += dppf<0x4E>(y0); y1 += dppf<0x4E>(y1);
                asm volatile("" : "+v"(y0), "+v"(y1));
                { const f32x2 yv = {y0, y1}; asm volatile("ds_write_b64 %0, %1" :: "v"(yaddr + (unsigned)(t * ystep)), "v"(yv)); }
                asm volatile("s_waitcnt lgkmcnt(0)" : "+v"(na), "+v"(nw), "+v"(nb), "+v"(nk), "+v"(nr), "+v"(nv));
            }
        }
        LDS_BARRIER();
    }
    {
        f32x4 y; { const LAS float* yq = (const LAS float*)(lds + 94208) + (tok * 32 + 2 * l16) * 8; const f32x4 v0 = *(const LAS f32x4*)yq, v1 = *(const LAS f32x4*)(yq + 4), v2 = *(const LAS f32x4*)(yq + 8), v3 = *(const LAS f32x4*)(yq + 12);
                  y = (f32x4){(v0.x + v0.z) + (v1.x + v1.z), (v0.y + v0.w) + (v1.y + v1.w), (v2.x + v2.z) + (v3.x + v3.z), (v2.y + v2.w) + (v3.y + v3.w)}; }
        const float mean = red16((y.x + y.y) + (y.z + y.w)) * (1.f / 64.f);
        const f32x4 d = y - mean;
        const float var = red16((d.x * d.x + d.y * d.y) + (d.z * d.z + d.w * d.w)) * (1.f / 64.f);
        const float rs = rsqrtf(var + LNX_EPS);
        const f32x4 o = (d * rs * lg + lb + prk * pvv) * pgg;
        u32x2 w; w.x = pk2(o.x, o.y); w.y = pk2(o.z, o.w);
        *(u32x2*)(MIX + ((size_t)b * SEQ + SEQ - 32 + tok) * D_MODEL + 512 + gc) = w;
    }
    __syncthreads();
}

#define XB_TMO      128
#define XB_XCNT(j)  (256  + 64 * (j))
#define XB_XSUB(j)  (1280 + 64 * (j))
#define XB_XGEN(j)  (2304 + 64 * (j))
#define XB_TOP      3328
#define XB_TOPGEN   3392
#define XCD_BAR_WORDS 3456
#define XB_SPIN_CAP (1u << 18)

__device__ __forceinline__ unsigned xb_ld(unsigned* p)              { return __hip_atomic_load(p, __ATOMIC_RELAXED, __HIP_MEMORY_SCOPE_AGENT); }
__device__ __forceinline__ unsigned xb_add(unsigned* p, unsigned v) { return __hip_atomic_fetch_add(p, v, __ATOMIC_RELAXED, __HIP_MEMORY_SCOPE_AGENT); }
__device__ __forceinline__ unsigned xb_xcc_id() { return (unsigned)__builtin_amdgcn_s_getreg((3 << 11) | 20) & 0xFu; }
#define XB_SPIN(cond, bar) do { unsigned _sp = 0; while (cond) { __builtin_amdgcn_s_sleep(1); \
    if ((++_sp & 255u) == 0u) { if (xb_ld(&(bar)[XB_TMO])) break; if (_sp > XB_SPIN_CAP) { atomicAdd(&(bar)[XB_TMO], 1u); break; } } } } while (0)

struct XcdBarrier {
    unsigned* bar; unsigned x;
    volatile LAS unsigned* st;
};

__device__ __forceinline__ XcdBarrier xcd_barrier_post(unsigned* bar, volatile LAS unsigned* st) {
    XcdBarrier b; b.bar = bar; b.x = xb_xcc_id(); b.st = st;
    if (threadIdx.x == 0) (void)xb_add(&bar[XB_XCNT(b.x)], 1u);
    return b;
}
__device__ __forceinline__ void xcd_barrier_complete(unsigned* bar, unsigned x, unsigned& nloc, unsigned& nx) {
    const unsigned G = gridDim.x * gridDim.y * gridDim.z;
    unsigned sum, cnt, mine, sp = 0u;
    for (;;) {
        sum = 0u; cnt = 0u; mine = 0u;
#pragma unroll
        for (unsigned j = 0; j < 16; ++j) { const unsigned c = xb_ld(&bar[XB_XCNT(j)]); sum += c; cnt += (c > 0u) ? 1u : 0u; mine = (j == x) ? c : mine; }
        if (sum == G) break;
        __builtin_amdgcn_s_sleep(1);
        if ((++sp & 255u) == 0u) { if (xb_ld(&bar[XB_TMO])) break; if (sp > XB_SPIN_CAP) { atomicAdd(&bar[XB_TMO], 1u); break; } }
    }
    nloc = mine > 0u ? mine : 1u; nx = cnt > 0u ? cnt : 1u;
}

__device__ __forceinline__ void xcd_barrier(const XcdBarrier& b) {
    asm volatile("s_waitcnt vmcnt(0)" ::: "memory");
    __syncthreads();
    if (threadIdx.x == 0) {
        unsigned* bar = b.bar;
        __builtin_amdgcn_s_waitcnt(0);
        unsigned nloc = b.st[0], nx = b.st[1];
        if (nloc == 0u) { xcd_barrier_complete(bar, b.x, nloc, nx); b.st[0] = nloc; b.st[1] = nx; }
        const unsigned old = xb_add(&bar[XB_XSUB(b.x)], 1u);
        const unsigned gen = old / nloc;
        if (old + 1u == (gen + 1u) * nloc) {
            __builtin_amdgcn_fence(__ATOMIC_RELEASE, "agent");
            asm volatile("s_waitcnt vmcnt(0)" ::: "memory");
            const unsigned og = xb_add(&bar[XB_TOP], 1u);
            const unsigned tg = og / nx;
            if (og + 1u == (tg + 1u) * nx) xb_add(&bar[XB_TOPGEN], 1u);
            else XB_SPIN(xb_ld(&bar[XB_TOPGEN]) == tg, bar);
            __builtin_amdgcn_fence(__ATOMIC_ACQUIRE, "agent");
            xb_add(&bar[XB_XGEN(b.x)], 1u);
            asm volatile("s_waitcnt vmcnt(0)" ::: "memory");
        } else {
            XB_SPIN(xb_ld(&bar[XB_XGEN(b.x)]) == gen, bar);
            __builtin_amdgcn_fence(__ATOMIC_ACQUIRE, "agent");
            asm volatile("s_waitcnt vmcnt(0)" ::: "memory");
        }
    }
    __syncthreads();
}

__device__ __forceinline__ void sub_barrier(unsigned* ctr, unsigned n) {
    asm volatile("s_waitcnt vmcnt(0)" ::: "memory");
    __syncthreads();
    if (threadIdx.x == 0) {
        __builtin_amdgcn_fence(__ATOMIC_RELEASE, "agent");
        asm volatile("s_waitcnt vmcnt(0)" ::: "memory");
        (void)__hip_atomic_fetch_add(ctr, 1u, __ATOMIC_RELAXED, __HIP_MEMORY_SCOPE_AGENT);
        unsigned sp = 0u;
        while (__hip_atomic_load(ctr, __ATOMIC_RELAXED, __HIP_MEMORY_SCOPE_AGENT) < n) { __builtin_amdgcn_s_sleep(2); if (++sp > (1u << 22)) break; }
        __builtin_amdgcn_fence(__ATOMIC_ACQUIRE, "agent");
        asm volatile("s_waitcnt vmcnt(0)" ::: "memory");
    }
    __syncthreads();
}
constexpr int MIXA_C0 = 1536;
constexpr int SUBBAR_WORD = 8192;
constexpr int N_PHASES = 16;
constexpr int XB_LDS_OFF = LDS_BYTES - 64, XB_WS_WORD = 4096;
__global__ void __launch_bounds__(NTHREADS, 2) mega_fwd(Args args) {
    extern __shared__ __attribute__((aligned(16))) unsigned char lds_raw[];
    LAS unsigned char* lds0 = (LAS unsigned char*)lds_raw;
    const Args* ap0 = (const Args*)__builtin_amdgcn_kernarg_segment_ptr();
    const int ph_lo = ap0->ph_lo, ph_hi = ap0->ph_hi;
    if (ph_hi - ph_lo > 1) {
        volatile LAS unsigned* bst = (volatile LAS unsigned*)(lds0 + XB_LDS_OFF);
        if (threadIdx.x < 2) bst[threadIdx.x] = 0u;
        __syncthreads();
        (void)xcd_barrier_post((unsigned*)(ap0->ws) + XB_WS_WORD, bst);
    }
    for (int ph = ph_lo; ph < ph_hi; ++ph) {
        const Args* ap = ap0; asm volatile("" : "+s"(ap));
        const Args& A = *ap;
        int tid = threadIdx.x; asm volatile("" : "+v"(tid));
        int G = gridDim.x, bid = blockIdx.x; asm volatile("" : "+s"(G), "+s"(bid));
        LAS unsigned char* lds = lds0; asm volatile("" : "+s"(lds));
        const int lane = tid & 63, wave = __builtin_amdgcn_readfirstlane(tid >> 6);
        const int gw = bid * NWAVES + wave, NGW = G * NWAVES;
        unsigned char* ws = A.ws;
        bool is_gemm = false; pg8::Gemm g{nullptr, nullptr, 0, 0, 0}; pg8::EpiU E{nullptr, 0, 0}; int gG = G, gc = bid;
        switch (ph) {
        case 0: prologue<0>(A, lds, gw, NGW, wave, lane); break;
        case 1: g = pg8::Gemm{(const bf16*)(ws + WS_XN), (const bf16*)(ws + WS_W1IN), M_TOK, 2 * D_FF, D_MODEL}; E = pg8::EpiU{(bf16*)(ws + WS_HU), D_FF, 1}; is_gemm = true; break;
        case 2: g = pg8::Gemm{(const bf16*)(ws + WS_HU), (const bf16*)(ws + WS_W1OUT), M_TOK, D_MODEL, D_FF}; E = pg8::EpiU{(bf16*)(ws + WS_Y), D_MODEL, 0}; is_gemm = true; break;
        case 3: norm_pass<false, true>((const bf16*)(ws + WS_Y), A.in[I_X], ws + WS_HB, 0.5f, A.in[I_F1POST], A.in[I_MIXPRE], (bf16*)(ws + WS_XN), gw, NGW, lane); break;
        case 4: g = pg8::Gemm{(const bf16*)(ws + WS_XN), (const bf16*)(ws + WS_WMIXIN) + (size_t)MIXA_C0 * D_MODEL, M_TOK, LDU - MIXA_C0, D_MODEL}; E = pg8::EpiU{(bf16*)(ws + WS_HU) + MIXA_C0, LDU, 0}; is_gemm = true; break;
        case 5: { const int nR = (G >= 256) ? 128 : (G / 2 > 0 ? G / 2 : 1);
                  if (bid >= nR) { g = pg8::Gemm{(const bf16*)(ws + WS_XN), (const bf16*)(ws + WS_WMIXIN), M_TOK, MIXA_C0, D_MODEL}; E = pg8::EpiU{(bf16*)(ws + WS_HU), LDU, 0}; is_gemm = true; gG = G - nR; gc = bid - nR; } } break;
        case 6: {
            const bf16* HU = (const bf16*)(ws + WS_HU); bf16* XN = (bf16*)(ws + WS_Y);
            const int nR = (G >= 256) ? 128 : (G / 2 > 0 ? G / 2 : 1);
            if (bid < nR) { for (int hd = bid; hd < BATCH * 8; hd += nR) rwkv_head(lds, A, HU, XN, hd >> 3, hd & 7, tid); }
            else { if (ph_hi - ph_lo > 1) sub_barrier((unsigned*)(ws) + SUBBAR_WORD, (unsigned)(G - nR));
                   for (int u = bid - nR; u < BATCH * 8 * 8; u += G - nR) { const int bh = u & 127, qb = 7 - (u >> 7); sb_unit(lds, HU, XN, A.in[I_SBG], bh >> 3, bh & 7, qb, tid); }
                   __syncthreads();
                   { const int sb = bid - nR, nsb = G - nR;
                     if (nsb == 128) { if (sb < 64) prologue<1>(A, lds, sb * NWAVES + wave, 2048, wave, lane);
                                       else { for (int k = 0; k < 3; ++k) { prologue<1>(A, lds, 512 + ((sb - 64) * NWAVES + wave) * 3 + k, 2048, wave, lane); } } }
                     else prologue<1>(A, lds, sb * NWAVES + wave, nsb * NWAVES, wave, lane); }
                   __syncthreads();
                   g = pg8::Gemm{(const bf16*)(ws + WS_MEMN), (const bf16*)(ws + WS_WKV), M_MEM, D_MODEL, D_MODEL}; E = pg8::EpiU{(bf16*)(ws + WS_KVM), D_MODEL, 0}; is_gemm = true; gG = G - nR; gc = bid - nR; }
        } break;
        case 7: g = pg8::Gemm{(const bf16*)(ws + WS_Y), (const bf16*)(ws + WS_WMIXOUT), M_TOK, D_MODEL, D_MODEL}; E = pg8::EpiU{(bf16*)(ws + WS_XN), D_MODEL, 0}; is_gemm = true; break;
        case 8: norm_pass<true, true>((const bf16*)(ws + WS_XN), ws + WS_HB, ws + WS_HB, 1.0f, A.in[I_MIXPOST], A.in[I_MEMPRE], (bf16*)(ws + WS_XN), gw, NGW, lane); break;
        case 9: g = pg8::Gemm{(const bf16*)(ws + WS_XN), (const bf16*)(ws + WS_WQ), M_TOK, MEM_W, D_MODEL}; E = pg8::EpiU{(bf16*)(ws + WS_QM), MEM_W, 0}; is_gemm = true; break;
        case 10: for (int pu = bid; pu < BATCH * 4 * 4; pu += G) { const int bm = pu >> 2, q0 = pu & 3, b = bm >> 2, mh = bm & 3;
                     __syncthreads(); xatt_stage(lds, (const bf16*)(ws + WS_KVM), b, mh, tid); __syncthreads();
                     xatt_unit(lds, (const bf16*)(ws + WS_QM), (bf16*)(ws + WS_OM), b, mh, q0, tid); xatt_unit(lds, (const bf16*)(ws + WS_QM), (bf16*)(ws + WS_OM), b, mh, q0 + 4, tid); } break;
        case 11: g = pg8::Gemm{(const bf16*)(ws + WS_OM), (const bf16*)(ws + WS_WO), M_TOK, D_MODEL, MEM_W}; E = pg8::EpiU{(bf16*)(ws + WS_Y), D_MODEL, 0}; is_gemm = true; break;
        case 12: norm_pass<true, true>((const bf16*)(ws + WS_Y), ws + WS_HB, ws + WS_HB, 1.0f, A.in[I_MEMPOST], A.in[I_F2PRE], (bf16*)(ws + WS_XN), gw, NGW, lane); break;
        case 13: g = pg8::Gemm{(const bf16*)(ws + WS_XN), (const bf16*)(ws + WS_W2IN), M_TOK, 2 * D_FF, D_MODEL}; E = pg8::EpiU{(bf16*)(ws + WS_HU), D_FF, 1}; is_gemm = true; break;
        case 14: g = pg8::Gemm{(const bf16*)(ws + WS_HU), (const bf16*)(ws + WS_W2OUT), M_TOK, D_MODEL, D_FF}; E = pg8::EpiU{(bf16*)(ws + WS_Y), D_MODEL, 0}; is_gemm = true; break;
        case 15: norm_pass<true, false>((const bf16*)(ws + WS_Y), ws + WS_HB, A.out, 0.5f, A.in[I_F2POST], nullptr, nullptr, gw, NGW, lane); break;
        default: break;
        }
        if (is_gemm) { pg8::StaticOrder S; S.init(g.M, g.N, gG, gc); pg8::gemm_phase<pg8::EpiU, pg8::StaticOrder, true, true>(lds, g, S, E, tid); }
        if (ph + 1 < ph_hi && ph != 5) {
            if (ph_hi > N_PHASES) { __syncthreads(); cg::this_grid().sync(); }
            else { XcdBarrier xb; xb.bar = (unsigned*)(A.ws) + XB_WS_WORD; xb.x = xb_xcc_id(); xb.st = (volatile LAS unsigned*)(lds + XB_LDS_OFF); xcd_barrier(xb); }
        }
    }
}

#ifndef MK_ONE_LAUNCH
#define MK_ONE_LAUNCH 1
#endif
extern "C" void kernel_launch(void* const* d_in, const int* in_sizes, int n_in, void* d_out, int out_size, void* d_ws, size_t ws_size, hipStream_t stream) {
    static int grid = 0;
    if (grid == 0) {
        if (n_in != N_IN || out_size != M_TOK * D_MODEL || ws_size < WS_END) { fprintf(stderr, "kernel_launch: unexpected shapes (n_in %d out %d ws %zu)\n", n_in, out_size, ws_size); grid = -1; return; }
        int dev = 0, cus = 0, per_cu = 0;
        if (hipGetDevice(&dev) != hipSuccess || hipDeviceGetAttribute(&cus, hipDeviceAttributeMultiprocessorCount, dev) != hipSuccess) { grid = -1; return; }
        if (hipFuncSetAttribute((const void*)mega_fwd, hipFuncAttributeMaxDynamicSharedMemorySize, LDS_BYTES) != hipSuccess) { fprintf(stderr, "kernel_launch: hipFuncSetAttribute failed\n"); grid = -1; return; }
        if (hipOccupancyMaxActiveBlocksPerMultiprocessor(&per_cu, (const void*)mega_fwd, NTHREADS, LDS_BYTES) != hipSuccess || per_cu < 1) { fprintf(stderr, "kernel_launch: occupancy query gave %d\n", per_cu); per_cu = 1; }
        (void)hipGetLastError();
        grid = cus;
    }
    if (grid < 0) return;
    if (hipMemsetAsync(d_ws, 0, 1u << 20, stream) != hipSuccess) { fprintf(stderr, "kernel_launch: memset of the control words failed\n"); return; }
    Args a{};
    for (int i = 0; i < N_IN; ++i) a.in[i] = (const float*)d_in[i];
    a.out = (float*)d_out; a.ws = (unsigned char*)d_ws;
#if MK_ONE_LAUNCH
    a.ph_lo = 0; a.ph_hi = N_PHASES;
    void* kargs[] = {&a};
    hipError_t e = hipLaunchCooperativeKernel((const void*)mega_fwd, dim3(grid), dim3(NTHREADS), kargs, LDS_BYTES, stream);
    if (e != hipSuccess) fprintf(stderr, "cooperative launch failed: %s (grid %d)\n", hipGetErrorString(e), grid);
#else
    for (int p = 0; p < N_PHASES; ++p) { a.ph_lo = p; a.ph_hi = p + 1; hipLaunchKernelGGL(mega_fwd, dim3(grid), dim3(NTHREADS), LDS_BYTES, stream, a); }
#endif
}
```

```cpp
#include <hip/hip_runtime.h>
#include <hip/hip_cooperative_groups.h>
#include <cstdio>
#include <cstdint>
namespace cg = cooperative_groups;
namespace pg8 {
#define PG8_LAS __attribute__((address_space(3)))
typedef unsigned short bf16_t;
typedef short bf16x8 __attribute__((ext_vector_type(8)));
typedef float f32x4 __attribute__((ext_vector_type(4)));
typedef unsigned u32x4 __attribute__((ext_vector_type(4)));
constexpr int BM = 256, BK = 64, HALF = 128, HTB = HALF * BK * 2  , STAGE_BYTES = 8 * HTB, NXCD = 8, WGM = 8;

__host__ __device__ __forceinline__ int lds_byte(int r, int c) { const int st = (r >> 4) * 2 + (c >> 5), rr = r & 15, cc = c & 31, ob = rr * 64 + cc * 2; return st * 1024 + (ob ^ (((ob >> 9) & 1) << 5)); }
__host__ __device__ __forceinline__ void stage_rc(int b, int& R, int& C) { const int st = b / 1024, sb = b % 1024, swz = sb ^ (((sb >> 9) & 1) << 5); R = (st >> 1) * 16 + swz / 64; C = (st & 1) * 32 + (swz % 64) / 2; }
__host__ __device__ __forceinline__ int perm32(int rho) { const int n = rho >> 4, i = rho & 15; return 8 * (i >> 2) + 4 * n + (i & 3); }

struct Unit { int pm, pn; };
struct Gemm { const bf16_t* A; const bf16_t* Bt; int M, N, K; };

struct StaticOrder {
    int nM, nN, nwg, G, c;
    __host__ __device__ void init(int M, int N, int G_, int c_) { nM = M / BM; nN = N / BM; nwg = nM * nN; G = G_; c = c_; }
    __host__ __device__ bool next(int i, Unit& u) const {
        const long L = (long)i * G + c; if (L >= nwg) return false;
        int wgid = (int)L; { const int q = nwg / NXCD, r = nwg % NXCD, xcd = wgid % NXCD, off = wgid / NXCD; wgid = (xcd < r ? xcd * (q + 1) : r * (q + 1) + (xcd - r) * q) + off; }
        const int nig = WGM * nN, gid = wgid / nig, fm = gid * WGM, gsz = (nM - fm) < WGM ? (nM - fm) : WGM;
        u.pm = fm + ((wgid % nig) % gsz); u.pn = (wgid % nig) / gsz; return true;
    }
    __device__ __forceinline__ void a_ready(const Unit&) const {}
    __device__ __forceinline__ void done(const Unit&) const {}
};
__device__ __forceinline__ unsigned cvt_pk_bf16(float lo, float hi) { unsigned r; asm volatile("v_cvt_pk_bf16_f32 %0, %1, %2" : "=v"(r) : "v"(lo), "v"(hi)); return r; }
typedef float f32x2 __attribute__((ext_vector_type(2)));
struct EpiU {
    static constexpr bool PERM = true, AFTER_DRAIN = false;
    bf16_t* O; int ldc; int mode;
    __device__ __forceinline__ void operator()(const f32x4 (&acc)[2][2][4][2], const Unit& u, int wr, int wc, int fr, int fq) const {
        const int row0 = u.pm * BM + wr * 64 + fr;
        if (mode == 0) {
            const int col0 = u.pn * BM + wc * 32 + 8 * fq;
#pragma unroll
            for (int ai = 0; ai < 2; ++ai)
#pragma unroll
                for (int m = 0; m < 4; ++m) { bf16_t* rowp = O + (size_t)(row0 + ai * HALF + m * 16) * ldc + col0;
#pragma unroll
                    for (int bj = 0; bj < 2; ++bj) { const f32x4 v0 = acc[ai][bj][m][0], v1 = acc[ai][bj][m][1];
                        u32x4 w; w.x = cvt_pk_bf16(v0[0], v0[1]); w.y = cvt_pk_bf16(v0[2], v0[3]); w.z = cvt_pk_bf16(v1[0], v1[1]); w.w = cvt_pk_bf16(v1[2], v1[3]);
                        *(u32x4*)(rowp + bj * HALF) = w; } }
        } else {
            const int col0 = u.pn * HALF + wc * 32 + 8 * fq;
#pragma unroll
            for (int ai = 0; ai < 2; ++ai)
#pragma unroll
                for (int m = 0; m < 4; ++m) { bf16_t* rowp = O + (size_t)(row0 + ai * HALF + m * 16) * ldc + col0;
                    float hv[8];
#pragma unroll
                    for (int n = 0; n < 2; ++n)
#pragma unroll
                        for (int j = 0; j < 4; ++j) { const float g = acc[ai][0][m][n][j], up = acc[ai][1][m][n][j];
                            hv[4 * n + j] = g * __builtin_amdgcn_rcpf(1.f + __expf(-g)) * up; }
                    u32x4 w; w.x = cvt_pk_bf16(hv[0], hv[1]); w.y = cvt_pk_bf16(hv[2], hv[3]); w.z = cvt_pk_bf16(hv[4], hv[5]); w.w = cvt_pk_bf16(hv[6], hv[7]);
                    *(u32x4*)rowp = w; }
        }
    }
};
template <class Epi, class Sched, bool ALIGN_EPI = false, bool SP2 = false>
__device__ __forceinline__ void gemm_phase(PG8_LAS unsigned char* lds, const Gemm g, const Sched& S, const Epi& E, const int tid) {
    const int wid = __builtin_amdgcn_readfirstlane(tid >> 6), lane = tid & 63, wr = wid >> 2, wc = wid & 3, fr = lane & 15, fq = lane >> 4;
    const int K = g.K, nt = K / BK;
    unsigned voffA[2], voffB[2];
#pragma unroll
    for (int i = 0; i < 2; ++i) { int R, C; stage_rc(tid * 16 + i * 8192, R, C); const int Rb = Epi::PERM ? ((R & ~31) + perm32(R & 31)) : R;
        voffA[i] = (unsigned)(R * K + C) * 2u; voffB[i] = (unsigned)(Rb * K + C) * 2u; }
    const size_t kstep = (size_t)(BK * 2);
    const size_t hstep = (size_t)HALF * K * 2;
    const size_t tstep = 2 * hstep;
    const unsigned ldsw = (unsigned)wid * 1024u;
    const int aoff = lds_byte(wr * 64 + fr, fq * 8), boff = lds_byte(wc * 32 + fr, fq * 8);
#define PG8_SA(b, h) (((b) * 2 + (h)) * HTB)
#define PG8_SB(b, h) ((4 + (b) * 2 + (h)) * HTB)
#define PG8_STAGE(bufoff, gbase, voff) do { _Pragma("unroll") for (int _i = 0; _i < 2; ++_i) \
        __builtin_amdgcn_global_load_lds((const unsigned*)((const char*)(gbase) + (voff)[_i]), (PG8_LAS unsigned*)(lds + (bufoff) + ldsw + _i * 8192), 16, 0, 0); } while (0)
#define PG8_LDA(dst, b, h) do { _Pragma("unroll") for (int m = 0; m < 4; ++m) _Pragma("unroll") for (int k = 0; k < 2; ++k) dst[m][k] = *(const PG8_LAS bf16x8*)(lds + PG8_SA(b, h) + aoff + m * 2048 + k * 1024); } while (0)
#define PG8_LDB(dst, b, h) do { _Pragma("unroll") for (int n = 0; n < 2; ++n) _Pragma("unroll") for (int k = 0; k < 2; ++k) dst[n][k] = *(const PG8_LAS bf16x8*)(lds + PG8_SB(b, h) + boff + n * 2048 + k * 1024); } while (0)
#define PG8_MMA(ai, bj, At, Bt) do { __builtin_amdgcn_s_setprio(1); _Pragma("unroll") for (int m = 0; m < 4; ++m) _Pragma("unroll") for (int n = 0; n < 2; ++n) _Pragma("unroll") for (int k = 0; k < 2; ++k) \
        acc[ai][bj][m][n] = __builtin_amdgcn_mfma_f32_16x16x32_bf16(Bt[n][k], At[m][k], acc[ai][bj][m][n], 0, 0, 0); __builtin_amdgcn_s_setprio(0); } while (0)
#define PG8_WAIT_V(n) asm volatile("s_waitcnt vmcnt(" #n ")" ::: "memory")
#define PG8_WAIT_L(n) asm volatile("s_waitcnt lgkmcnt(" #n ")" ::: "memory")
#define PG8_BAR __builtin_amdgcn_s_barrier()
#define PG8_SCHED __builtin_amdgcn_sched_barrier(0)
    Unit cur, nxt; int ui = 0;
    if (!S.next(0, cur)) return;
    f32x4 acc[2][2][4][2];
#pragma unroll
    for (int a = 0; a < 2; ++a)
#pragma unroll
        for (int b = 0; b < 2; ++b)
#pragma unroll
            for (int m = 0; m < 4; ++m)
#pragma unroll
                for (int n = 0; n < 2; ++n) acc[a][b][m][n] = (f32x4){0.f, 0.f, 0.f, 0.f};
    bf16x8 At[4][2], B0[2][2], B1[2][2];
    const char* cA = (const char*)g.A + (size_t)cur.pm * tstep; const char* cB = (const char*)g.Bt + (size_t)cur.pn * tstep;
    S.a_ready(cur);
    if constexpr (SP2) {
        PG8_STAGE(PG8_SB(0, 0), cB, voffB); PG8_STAGE(PG8_SB(0, 1), cB + hstep, voffB); PG8_STAGE(PG8_SA(0, 0), cA, voffA); PG8_STAGE(PG8_SA(0, 1), cA + hstep, voffA);
        if (wr == 1) PG8_BAR;
        PG8_WAIT_V(2); PG8_BAR;
        PG8_STAGE(PG8_SB(1, 0), cB + kstep, voffB); PG8_STAGE(PG8_SA(1, 0), cA + kstep, voffA); PG8_STAGE(PG8_SB(1, 1), cB + hstep + kstep, voffB);
        PG8_WAIT_V(6); PG8_BAR;
    } else {
        PG8_STAGE(PG8_SB(0, 0), cB, voffB); PG8_STAGE(PG8_SA(0, 0), cA, voffA); PG8_STAGE(PG8_SB(0, 1), cB + hstep, voffB); PG8_STAGE(PG8_SA(0, 1), cA + hstep, voffA);
        if (wr == 1) PG8_BAR;
        PG8_WAIT_V(4); PG8_BAR;
        PG8_STAGE(PG8_SB(1, 0), cB + kstep, voffB); PG8_STAGE(PG8_SA(1, 0), cA + kstep, voffA); PG8_STAGE(PG8_SB(1, 1), cB + hstep + kstep, voffB);
        PG8_WAIT_V(6); PG8_BAR;
    }
    for (;;) {
        const bool has_next = S.next(ui + 1, nxt);
        const char* nA = has_next ? (const char*)g.A + (size_t)nxt.pm * tstep : cA; const char* nB = has_next ? (const char*)g.Bt + (size_t)nxt.pn * tstep : cB;
        for (int t = 0; t < nt; t += 2) {
            const bool last = (t == nt - 2);
            const char* a1 = cA + (size_t)(t + 1) * kstep;
            const char* a2 = last ? nA : cA + (size_t)(t + 2) * kstep; const char* b2 = last ? nB : cB + (size_t)(t + 2) * kstep;
            const char* a3 = a2 + kstep; const char* b3 = b2 + kstep;
            if (last && has_next) S.a_ready(nxt);
            if constexpr (SP2) {
            PG8_LDB(B0, 0, 0); PG8_LDB(B1, 0, 1); PG8_SCHED; PG8_LDA(At, 0, 0); PG8_STAGE(PG8_SA(1, 1), a1 + hstep, voffA);
            PG8_WAIT_V(8); PG8_WAIT_L(0); PG8_BAR; PG8_MMA(0, 0, At, B0); PG8_MMA(0, 1, At, B1); PG8_BAR; PG8_SCHED;
            PG8_LDA(At, 0, 1); PG8_STAGE(PG8_SB(0, 0), b2, voffB); PG8_STAGE(PG8_SB(0, 1), b2 + hstep, voffB); PG8_STAGE(PG8_SA(0, 0), a2, voffA);
            PG8_WAIT_V(8); PG8_WAIT_L(0); PG8_BAR; PG8_MMA(1, 0, At, B0); PG8_MMA(1, 1, At, B1); PG8_BAR; PG8_SCHED;
            PG8_LDB(B0, 1, 0); PG8_LDB(B1, 1, 1); PG8_SCHED; PG8_LDA(At, 1, 0); PG8_STAGE(PG8_SA(0, 1), a2 + hstep, voffA);
            PG8_WAIT_V(8); PG8_WAIT_L(0); PG8_BAR; PG8_MMA(0, 0, At, B0); PG8_MMA(0, 1, At, B1); PG8_BAR; PG8_SCHED;
            PG8_LDA(At, 1, 1); PG8_STAGE(PG8_SB(1, 0), b3, voffB); PG8_STAGE(PG8_SB(1, 1), b3 + hstep, voffB); PG8_STAGE(PG8_SA(1, 0), a3, voffA);
            PG8_WAIT_V(8); PG8_WAIT_L(0); PG8_BAR; PG8_MMA(1, 0, At, B0); PG8_MMA(1, 1, At, B1); PG8_BAR; PG8_SCHED;
            } else {
            PG8_LDB(B0, 0, 0); PG8_SCHED; PG8_LDA(At, 0, 0); PG8_STAGE(PG8_SA(1, 1), a1 + hstep, voffA);
            PG8_WAIT_L(8); PG8_BAR; PG8_WAIT_L(0); PG8_MMA(0, 0, At, B0); PG8_BAR; PG8_SCHED;
            PG8_LDB(B1, 0, 1); PG8_STAGE(PG8_SB(0, 0), b2, voffB);
            PG8_BAR; PG8_WAIT_L(0); PG8_MMA(0, 1, At, B1); PG8_BAR;
            PG8_LDA(At, 0, 1); PG8_STAGE(PG8_SA(0, 0), a2, voffA);
            PG8_BAR; PG8_WAIT_L(0); PG8_MMA(1, 0, At, B0); PG8_BAR; PG8_SCHED;
            PG8_STAGE(PG8_SB(0, 1), b2 + hstep, voffB);
            PG8_WAIT_V(6); PG8_BAR; PG8_MMA(1, 1, At, B1); PG8_BAR;
            PG8_LDB(B0, 1, 0); PG8_SCHED; PG8_LDA(At, 1, 0); PG8_STAGE(PG8_SA(0, 1), a2 + hstep, voffA);
            PG8_WAIT_L(8); PG8_BAR; PG8_WAIT_L(0); PG8_MMA(0, 0, At, B0); PG8_BAR; PG8_SCHED;
            PG8_LDB(B1, 1, 1); PG8_STAGE(PG8_SB(1, 0), b3, voffB);
            PG8_BAR; PG8_WAIT_L(0); PG8_MMA(0, 1, At, B1); PG8_BAR;
            PG8_LDA(At, 1, 1); PG8_STAGE(PG8_SA(1, 0), a3, voffA);
            PG8_BAR; PG8_WAIT_L(0); PG8_MMA(1, 0, At, B0); PG8_BAR; PG8_SCHED;
            PG8_STAGE(PG8_SB(1, 1), b3 + hstep, voffB);
            PG8_WAIT_V(6); PG8_BAR; PG8_MMA(1, 1, At, B1); PG8_BAR;
            }
        }
        if constexpr (ALIGN_EPI) { if (wr == 0) PG8_BAR; }
        if constexpr (!Epi::AFTER_DRAIN) { E(acc, cur, wr, wc, fr, fq); S.done(cur); }
        if (!has_next) break;
#pragma unroll
        for (int a = 0; a < 2; ++a)
#pragma unroll
            for (int b = 0; b < 2; ++b)
#pragma unroll
                for (int m = 0; m < 4; ++m)
#pragma unroll
                    for (int n = 0; n < 2; ++n) acc[a][b][m][n] = (f32x4){0.f, 0.f, 0.f, 0.f};
        cur = nxt; cA = nA; cB = nB; ++ui;
        if constexpr (ALIGN_EPI) { if (wr == 1) PG8_BAR; }
    }
    PG8_WAIT_V(0);
    if constexpr (!ALIGN_EPI) { if (wr == 0) PG8_BAR; }
    PG8_BAR;
    if constexpr (Epi::AFTER_DRAIN) { E.fused(acc, cur, wr, wc, fr, fq, lds, wid, lane); S.done(cur); }
#undef PG8_SA
#undef PG8_SB
#undef PG8_STAGE
#undef PG8_LDA
#undef PG8_LDB
#undef PG8_MMA
#undef PG8_WAIT_V
#undef PG8_WAIT_L
#undef PG8_BAR
#undef PG8_SCHED
}
}

constexpr int D_MODEL = 1024, BATCH = 16, SEQ = 2048, M_TOK = BATCH * SEQ;
constexpr int MEM_LEN = 256, M_MEM = BATCH * MEM_LEN;
constexpr int D_FF = 2816, MIX_IN = 3360, LDU = 3584, RW_OFF = 1536, RWKV_IN = 1824;
constexpr int MEM_W = 512;
constexpr float NORM_EPS = 1e-6f, LNX_EPS = 64e-5f;
constexpr int NWAVES = 8, NTHREADS = 512;
constexpr int LDS_BYTES = 147456;
enum { I_X = 0, I_MEM, I_F1PRE, I_F1POST, I_F1WIN, I_F1WOUT, I_MIXPRE, I_MIXPOST, I_MIXWIN, I_MU, I_W0, I_W2, I_A0, I_A2, I_G2, I_KK, I_KA, I_RK, I_LNG, I_LNB,
       I_SBG, I_MIXWOUT, I_MEMPRE, I_MEMPOST, I_MEMKVG, I_WQ, I_WKV, I_WO, I_F2PRE, I_F2POST, I_F2WIN, I_F2WOUT, N_IN };
constexpr size_t MiB = 1u << 20;
constexpr size_t WS_W1IN = 2 * MiB, WS_W1OUT = 13 * MiB, WS_WMIXIN = 19 * MiB, WS_WMIXOUT = 26 * MiB, WS_WQ = 28 * MiB, WS_WKV = 29 * MiB, WS_WO = 31 * MiB,
                 WS_W2IN = 32 * MiB, WS_W2OUT = 43 * MiB, WS_LW2 = 49 * MiB, WS_LA2 = WS_LW2 + 65536, WS_LG2 = WS_LA2 + 65536,
                 WS_MEMN = 56 * MiB, WS_KVM = 64 * MiB, WS_XN = 72 * MiB, WS_Y = 136 * MiB, WS_HU = 200 * MiB, WS_HB = 424 * MiB, WS_END = 488 * MiB;
constexpr size_t WS_QM = WS_HU, WS_OM = WS_HU + 32 * MiB;

#define LAS __attribute__((address_space(3)))
typedef unsigned short bf16;
typedef short bf16x8 __attribute__((ext_vector_type(8)));
typedef short s16x4 __attribute__((ext_vector_type(4)));
typedef float f32x4 __attribute__((ext_vector_type(4)));
typedef float f32x2 __attribute__((ext_vector_type(2)));
typedef float f32x16 __attribute__((ext_vector_type(16)));
typedef unsigned u32x4 __attribute__((ext_vector_type(4)));
typedef unsigned u32x2 __attribute__((ext_vector_type(2)));

__device__ __forceinline__ float bflo(unsigned u) { return __uint_as_float(u << 16); }
__device__ __forceinline__ float bfhi(unsigned u) { return __uint_as_float(u & 0xffff0000u); }
__device__ __forceinline__ unsigned pk2(float lo, float hi) { return pg8::cvt_pk_bf16(lo, hi); }
template <int CTRL> __device__ __forceinline__ float dppf(float x) { return __builtin_bit_cast(float, __builtin_amdgcn_mov_dpp(__builtin_bit_cast(int, x), CTRL, 0xf, 0xf, true)); }
__device__ __forceinline__ float red16(float x) { x += dppf<0xB1>(x); x += dppf<0x4E>(x); x += dppf<0x141>(x); x += dppf<0x140>(x); return x; }
__device__ __forceinline__ float half_sum(float x) { auto t = __builtin_amdgcn_permlane32_swap(__float_as_uint(x), __float_as_uint(x), false, false); return __uint_as_float(t[0]) + __uint_as_float(t[1]); }
__device__ __forceinline__ float half_max(float x) { auto t = __builtin_amdgcn_permlane32_swap(__float_as_uint(x), __float_as_uint(x), false, false); return fmaxf(__uint_as_float(t[0]), __uint_as_float(t[1])); }
__device__ __forceinline__ float half_other(float x, int hi) { auto t = __builtin_amdgcn_permlane32_swap(__float_as_uint(x), __float_as_uint(x), false, false); return hi ? __uint_as_float(t[0]) : __uint_as_float(t[1]); }
__device__ __forceinline__ float wave_sum(float v) {
    v = red16(v);
    auto s = __builtin_amdgcn_permlane16_swap(__float_as_uint(v), __float_as_uint(v), false, false);
    v = __uint_as_float(s[0]) + __uint_as_float(s[1]);
    return half_sum(v);
}
#define LDS_BARRIER() do { asm volatile("s_waitcnt lgkmcnt(0)" ::: "memory"); __builtin_amdgcn_s_barrier(); asm volatile("" ::: "memory"); } while (0)
#define MFMA32(a, b, c) __builtin_amdgcn_mfma_f32_32x32x16_bf16((a), (b), (c), 0, 0, 0)

struct Args { const float* in[N_IN]; float* out; unsigned char* ws; int ph_lo, ph_hi; };

__device__ __forceinline__ void transpose_item(const float* W, int K, int N, bf16* WT, int ldk, int k0, int n0, int drow0, LAS float* scr, int lane) {
    float tv[32];
#pragma unroll
    for (int i = 0; i < 32; ++i) { const int k = k0 + 2 * i + (lane >> 5); tv[i] = (k < K) ? W[(size_t)k * N + n0 + (lane & 31)] : 0.f; }
#pragma unroll
    for (int i = 0; i < 32; ++i) scr[(2 * i + (lane >> 5)) * 33 + (lane & 31)] = tv[i];
    asm volatile("s_waitcnt lgkmcnt(0)" ::: "memory");
    const int c = lane & 7;
#pragma unroll
    for (int j = 0; j < 4; ++j) { const int n = (lane >> 3) + 8 * j; const LAS float* s = scr + (8 * c) * 33 + n;
        u32x4 o; o.x = pk2(s[0 * 33], s[1 * 33]); o.y = pk2(s[2 * 33], s[3 * 33]); o.z = pk2(s[4 * 33], s[5 * 33]); o.w = pk2(s[6 * 33], s[7 * 33]);
        if (k0 + 8 * c + 8 <= ldk) *(u32x4*)(WT + (size_t)(drow0 + n) * ldk + k0 + 8 * c) = o; }
    asm volatile("s_waitcnt lgkmcnt(0)" ::: "memory");
}
__device__ __forceinline__ void transpose_matrix_item(const float* W, int K, int N, bf16* WT, int ldk, int mode, int item, LAS float* scr, int lane) {
    const int nblk = N / 32, kb = item / nblk, nb = item % nblk, n0 = 32 * nb;
    int drow0 = n0;
    if (mode == 1) { drow0 = (n0 < D_FF) ? (n0 / 128) * 256 + (n0 % 128) : ((n0 - D_FF) / 128) * 256 + 128 + ((n0 - D_FF) % 128); }
    transpose_item(W, K, N, WT, ldk, 64 * kb, n0, drow0, scr, lane);
}
__device__ __forceinline__ void rms_rows2_to_bf16(const float* xrow, const float* g, bf16* orow, int lane) {
    const f32x4* gr = (const f32x4*)g + lane;
    f32x4 v[2][4]; float s[2] = {0.f, 0.f};
#pragma unroll
    for (int q = 0; q < 2; ++q) { const f32x4* xr = (const f32x4*)(xrow + (size_t)q * D_MODEL) + lane;
#pragma unroll
        for (int j = 0; j < 4; ++j) v[q][j] = xr[64 * j]; }
#pragma unroll
    for (int q = 0; q < 2; ++q)
#pragma unroll
        for (int j = 0; j < 4; ++j) s[q] += (v[q][j].x * v[q][j].x + v[q][j].y * v[q][j].y) + (v[q][j].z * v[q][j].z + v[q][j].w * v[q][j].w);
#pragma unroll
    for (int q = 0; q < 2; ++q) {
        const float rs = rsqrtf(wave_sum(s[q]) * (1.f / D_MODEL) + NORM_EPS);
        u32x2* o8 = (u32x2*)(orow + (size_t)q * D_MODEL) + lane;
#pragma unroll
        for (int j = 0; j < 4; ++j) { const f32x4 gg = gr[64 * j]; u32x2 o; o.x = pk2(v[q][j].x * rs * gg.x, v[q][j].y * rs * gg.y); o.y = pk2(v[q][j].z * rs * gg.z, v[q][j].w * rs * gg.w); o8[64 * j] = o; }
    }
}
template <int PART>
__device__ __forceinline__ void prologue(const Args& a, LAS unsigned char* lds, int gw, int NGW, int wave, int lane) {
    LAS float* scr = (LAS float*)(lds + wave * 16384);
    unsigned char* ws = a.ws;
    constexpr int I_FIN = (D_MODEL / 64) * (2 * D_FF / 32), I_FOUT = (D_FF / 64) * (D_MODEL / 32), I_MIN = (D_MODEL / 64) * (MIX_IN / 32), I_SQ = (D_MODEL / 64) * (D_MODEL / 32),
                  I_Q = (D_MODEL / 64) * (MEM_W / 32), I_O = (MEM_W / 64) * (D_MODEL / 32), I_L64 = 16, I_L160 = 48;
    if (PART == 0) {
        constexpr int NITEMS = I_FIN + I_FOUT + I_MIN + I_SQ + 2 * I_L64 + I_L160;
        for (int it = gw; it < NITEMS; it += NGW) {
            int r = it;
            if (r < I_FIN) { transpose_matrix_item(a.in[I_F1WIN], D_MODEL, 2 * D_FF, (bf16*)(ws + WS_W1IN), D_MODEL, 1, r, scr, lane); continue; } r -= I_FIN;
            if (r < I_FOUT) { transpose_matrix_item(a.in[I_F1WOUT], D_FF, D_MODEL, (bf16*)(ws + WS_W1OUT), D_FF, 0, r, scr, lane); continue; } r -= I_FOUT;
            if (r < I_MIN) { transpose_matrix_item(a.in[I_MIXWIN], D_MODEL, MIX_IN, (bf16*)(ws + WS_WMIXIN), D_MODEL, 0, r, scr, lane); continue; } r -= I_MIN;
            if (r < I_SQ) { transpose_matrix_item(a.in[I_WKV], D_MODEL, D_MODEL, (bf16*)(ws + WS_WKV), D_MODEL, 0, r, scr, lane); continue; } r -= I_SQ;
            if (r < I_L64) { transpose_matrix_item(a.in[I_W2], 64, 512, (bf16*)(ws + WS_LW2), 64, 0, r, scr, lane); continue; } r -= I_L64;
            if (r < I_L64) { transpose_matrix_item(a.in[I_A2], 64, 512, (bf16*)(ws + WS_LA2), 64, 0, r, scr, lane); continue; } r -= I_L64;
            transpose_matrix_item(a.in[I_G2], 160, 512, (bf16*)(ws + WS_LG2), 160, 0, r, scr, lane);
        }
        { u32x4* z = (u32x4*)((bf16*)(ws + WS_WMIXIN) + (size_t)MIX_IN * D_MODEL); const int n16 = (LDU - MIX_IN) * D_MODEL * 2 / 16;
          for (int i = gw * 64 + lane; i < n16; i += NGW * 64) z[i] = (u32x4){0u, 0u, 0u, 0u}; }
        for (int m = 2 * gw; m < M_TOK; m += 2 * NGW) rms_rows2_to_bf16(a.in[I_X] + (size_t)m * D_MODEL, a.in[I_F1PRE], (bf16*)(ws + WS_XN) + (size_t)m * D_MODEL, lane);
        for (int m = 2 * gw; m < M_MEM; m += 2 * NGW) rms_rows2_to_bf16(a.in[I_MEM] + (size_t)m * D_MODEL, a.in[I_MEMKVG], (bf16*)(ws + WS_MEMN) + (size_t)m * D_MODEL, lane);
    } else {
        constexpr int NITEMS = I_FIN + I_FOUT + I_SQ + I_Q + I_O;
        for (int it = gw; it < NITEMS; it += NGW) {
            int r = it;
            if (r < I_SQ) { transpose_matrix_item(a.in[I_MIXWOUT], D_MODEL, D_MODEL, (bf16*)(ws + WS_WMIXOUT), D_MODEL, 0, r, scr, lane); continue; } r -= I_SQ;
            if (r < I_Q) { transpose_matrix_item(a.in[I_WQ], D_MODEL, MEM_W, (bf16*)(ws + WS_WQ), D_MODEL, 0, r, scr, lane); continue; } r -= I_Q;
            if (r < I_O) { transpose_matrix_item(a.in[I_WO], MEM_W, D_MODEL, (bf16*)(ws + WS_WO), MEM_W, 0, r, scr, lane); continue; } r -= I_O;
            if (r < I_FIN) { transpose_matrix_item(a.in[I_F2WIN], D_MODEL, 2 * D_FF, (bf16*)(ws + WS_W2IN), D_MODEL, 1, r, scr, lane); continue; } r -= I_FIN;
            transpose_matrix_item(a.in[I_F2WOUT], D_FF, D_MODEL, (bf16*)(ws + WS_W2OUT), D_FF, 0, r, scr, lane);
        }
    }
}
template <bool HIN_BF, bool HOUT_BF>
__device__ __forceinline__ void norm_pass(const bf16* Y, const void* hin_, void* hout_, float coef, const float* gpost, const float* gpre, bf16* XN, int gw, int NGW, int lane) {
    f32x4 gp[4], gq[4];
#pragma unroll
    for (int j = 0; j < 4; ++j) { gp[j] = ((const f32x4*)gpost + lane)[64 * j]; gq[j] = gpre ? ((const f32x4*)gpre + lane)[64 * j] : (f32x4){0.f, 0.f, 0.f, 0.f}; }
    u32x2 ry[2][4]; u32x2 rhb[2][4]; f32x4 rhf[2][4];
#define NP_LOAD(r0) do { _Pragma("unroll") for (int q = 0; q < 2; ++q) { \
        const u32x2* yr = (const u32x2*)(Y + (size_t)((r0) + q) * D_MODEL) + lane; \
        _Pragma("unroll") for (int j = 0; j < 4; ++j) ry[q][j] = yr[64 * j]; \
        if (HIN_BF) { const u32x2* hr = (const u32x2*)((const bf16*)hin_ + (size_t)((r0) + q) * D_MODEL) + lane; _Pragma("unroll") for (int j = 0; j < 4; ++j) rhb[q][j] = hr[64 * j]; } \
        else { const f32x4* hr = (const f32x4*)((const float*)hin_ + (size_t)((r0) + q) * D_MODEL) + lane; _Pragma("unroll") for (int j = 0; j < 4; ++j) rhf[q][j] = hr[64 * j]; } } } while (0)
    int row0 = 2 * gw;
    if (row0 < M_TOK) NP_LOAD(row0);
    for (; row0 < M_TOK; row0 += 2 * NGW) {
        f32x4 y[2][4], h[2][4]; float s[2] = {0.f, 0.f};
#pragma unroll
        for (int q = 0; q < 2; ++q)
#pragma unroll
            for (int j = 0; j < 4; ++j) { const u32x2 t = ry[q][j]; y[q][j] = (f32x4){bflo(t.x), bfhi(t.x), bflo(t.y), bfhi(t.y)};
                if (HIN_BF) { const u32x2 u = rhb[q][j]; h[q][j] = (f32x4){bflo(u.x), bfhi(u.x), bflo(u.y), bfhi(u.y)}; } else h[q][j] = rhf[q][j]; }
        if (row0 + 2 * NGW < M_TOK) NP_LOAD(row0 + 2 * NGW);
#pragma unroll
        for (int q = 0; q < 2; ++q)
#pragma unroll
            for (int j = 0; j < 4; ++j) s[q] += (y[q][j].x * y[q][j].x + y[q][j].y * y[q][j].y) + (y[q][j].z * y[q][j].z + y[q][j].w * y[q][j].w);
#pragma unroll
        for (int q = 0; q < 2; ++q) {
            const float rs = rsqrtf(wave_sum(s[q]) * (1.f / D_MODEL) + NORM_EPS) * coef;
            float s2 = 0.f;
#pragma unroll
            for (int j = 0; j < 4; ++j) { h[q][j] = h[q][j] + y[q][j] * rs * gp[j];
                s2 += (h[q][j].x * h[q][j].x + h[q][j].y * h[q][j].y) + (h[q][j].z * h[q][j].z + h[q][j].w * h[q][j].w); }
            if (HOUT_BF) { u32x2* orow = (u32x2*)((bf16*)hout_ + (size_t)(row0 + q) * D_MODEL) + lane;
#pragma unroll
                for (int j = 0; j < 4; ++j) { u32x2 o; o.x = pk2(h[q][j].x, h[q][j].y); o.y = pk2(h[q][j].z, h[q][j].w); orow[64 * j] = o; } }
            else { f32x4* orow = (f32x4*)((float*)hout_ + (size_t)(row0 + q) * D_MODEL) + lane;
#pragma unroll
                for (int j = 0; j < 4; ++j) orow[64 * j] = h[q][j]; }
            if (gpre) {
                const float rs2 = rsqrtf(wave_sum(s2) * (1.f / D_MODEL) + NORM_EPS);
                u32x2* o8 = (u32x2*)(XN + (size_t)(row0 + q) * D_MODEL) + lane;
#pragma unroll
                for (int j = 0; j < 4; ++j) { const f32x4 g = gq[j]; u32x2 o; o.x = pk2(h[q][j].x * rs2 * g.x, h[q][j].y * rs2 * g.y); o.y = pk2(h[q][j].z * rs2 * g.z, h[q][j].w * rs2 * g.w); o8[64 * j] = o; }
            }
        }
    }
#undef NP_LOAD
}
constexpr int SB_KP = 72, SB_VP = 72;
typedef short v4i16_t __attribute__((ext_vector_type(4)));
__device__ __forceinline__ s16x4 lds_tr16(const LAS bf16* p) { return __builtin_bit_cast(s16x4, __builtin_amdgcn_ds_read_tr16_b64_v4i16((LAS v4i16_t*)p)); }
__device__ __forceinline__ void sb_unit(LAS unsigned char* lds, const bf16* U, bf16* MIX, const float* sbg, int b, int h, int qb, const int tid) {
    const int wave = tid >> 6, lane = tid & 63, j = lane & 31, hi = lane >> 5;
    LAS bf16* Ks = (LAS bf16*)lds;
    LAS bf16* Vt = (LAS bf16*)(lds + 64 * SB_KP * 2);
    const int qw = 256 * qb + 32 * wave;
    const size_t rowbase = (size_t)b * SEQ;
    bf16x8 qf[4];
    { const bf16* qp = U + (rowbase + qw + j) * LDU + h * 64 + 8 * hi;
#pragma unroll
      for (int ks = 0; ks < 4; ++ks) { const u32x4 raw = *(const u32x4*)(qp + 16 * ks); u32x4 sc;
          const float qs = 0.125f * 1.4426950408889634f;
          sc.x = pk2(bflo(raw.x) * qs, bfhi(raw.x) * qs); sc.y = pk2(bflo(raw.y) * qs, bfhi(raw.y) * qs);
          sc.z = pk2(bflo(raw.z) * qs, bfhi(raw.z) * qs); sc.w = pk2(bflo(raw.w) * qs, bfhi(raw.w) * qs);
          qf[ks] = __builtin_bit_cast(bf16x8, sc); } }
    f32x16 o0, o1;
#pragma unroll
    for (int r = 0; r < 16; ++r) { o0[r] = 0.f; o1[r] = 0.f; }
    float carry = 1.f;
    const int st_key = tid >> 3, st_dg = tid & 7;
    const bf16* kp0 = U + (rowbase + st_key) * LDU + 512 + h * 64 + 8 * st_dg;
    u32x4 kv = *(const u32x4*)(kp0 + (size_t)(64 * (4 * qb + 3)) * LDU), vv = *(const u32x4*)(kp0 + (size_t)(64 * (4 * qb + 3)) * LDU + 512);
    for (int jt = 4 * qb + 3; jt >= 0; --jt) {
        LDS_BARRIER();
        { *(LAS u32x4*)(Ks + st_key * SB_KP + 8 * st_dg) = kv;
          *(LAS u32x4*)(Vt + st_key * SB_VP + 8 * st_dg) = vv; }
        LDS_BARRIER();
        if (jt > 0) { kv = *(const u32x4*)(kp0 + (size_t)(64 * (jt - 1)) * LDU); vv = *(const u32x4*)(kp0 + (size_t)(64 * (jt - 1)) * LDU + 512); }
#pragma unroll 1
        for (int sub = 1; sub >= 0; --sub) {
            const int kbase = 64 * jt + 32 * sub;
            if (kbase > qw) continue;
            f32x16 acc;
#pragma unroll
            for (int r = 0; r < 16; ++r) acc[r] = 0.f;
#pragma unroll
            for (int ks = 0; ks < 4; ++ks) { const bf16x8 a = *(const LAS bf16x8*)(Ks + (32 * sub + j) * SB_KP + 16 * ks + 8 * hi); acc = MFMA32(a, qf[ks], acc); }
            const bool diag = (kbase == qw);
            float e[16], incl[16];
#pragma unroll
            for (int r = 0; r < 16; ++r) { const int i = 8 * (r >> 2) + 4 * hi + (r & 3); const float z = fminf(acc[r], 115.f);
                float ev = __builtin_amdgcn_exp2f(z); float dv = __builtin_amdgcn_rcpf(1.f + ev);
                if (diag && i >= j) { ev = 0.f; dv = 1.f; }
                e[r] = ev; incl[r] = dv; }
            float GP[4], GPo[4];
#pragma unroll
            for (int g = 0; g < 4; ++g) { incl[4 * g + 2] *= incl[4 * g + 3]; incl[4 * g + 1] *= incl[4 * g + 2]; incl[4 * g] *= incl[4 * g + 1]; GP[g] = incl[4 * g]; GPo[g] = half_other(GP[g], hi); }
            float ma[4], oi[4], base[4];
            ma[3] = 1.f; ma[2] = GP[3]; ma[1] = GP[2] * ma[2]; ma[0] = GP[1] * ma[1];
            oi[3] = GPo[3]; oi[2] = GPo[2] * oi[3]; oi[1] = GPo[1] * oi[2]; oi[0] = GPo[0] * oi[1];
            base[0] = carry * ma[0] * (hi ? oi[1] : oi[0]); base[1] = carry * ma[1] * (hi ? oi[2] : oi[1]);
            base[2] = carry * ma[2] * (hi ? oi[3] : oi[2]); base[3] = carry * ma[3] * (hi ? 1.f : oi[3]);
            carry = carry * ((GP[0] * ma[0]) * oi[0]);
            u32x4 p0, p1;
            p0.x = pk2(e[0] * incl[0] * base[0], e[1] * incl[1] * base[0]); p0.y = pk2(e[2] * incl[2] * base[0], e[3] * incl[3] * base[0]);
            p0.z = pk2(e[4] * incl[4] * base[1], e[5] * incl[5] * base[1]); p0.w = pk2(e[6] * incl[6] * base[1], e[7] * incl[7] * base[1]);
            p1.x = pk2(e[8] * incl[8] * base[2], e[9] * incl[9] * base[2]); p1.y = pk2(e[10] * incl[10] * base[2], e[11] * incl[11] * base[2]);
            p1.z = pk2(e[12] * incl[12] * base[3], e[13] * incl[13] * base[3]); p1.w = pk2(e[14] * incl[14] * base[3], e[15] * incl[15] * base[3]);
            const bf16x8 pa0 = __builtin_bit_cast(bf16x8, p0), pa1 = __builtin_bit_cast(bf16x8, p1);
#pragma unroll
            for (int s = 0; s < 2; ++s) {
                const bf16x8 pb = s ? pa1 : pa0;
                const LAS bf16* vp = Vt + (32 * sub + 16 * s + 4 * hi + ((lane & 15) >> 2)) * SB_VP + 16 * ((lane >> 4) & 1) + 4 * (lane & 3);
                { const s16x4 lo = lds_tr16(vp), hh = lds_tr16(vp + 8 * SB_VP); const bf16x8 va = __builtin_shufflevector(lo, hh, 0, 1, 2, 3, 4, 5, 6, 7); o0 = MFMA32(va, pb, o0); }
                { const s16x4 lo = lds_tr16(vp + 32), hh = lds_tr16(vp + 8 * SB_VP + 32); const bf16x8 va = __builtin_shufflevector(lo, hh, 0, 1, 2, 3, 4, 5, 6, 7); o1 = MFMA32(va, pb, o1); }
            }
        }
    }
    float ss = 0.f;
#pragma unroll
    for (int r = 0; r < 16; ++r) ss += o0[r] * o0[r] + o1[r] * o1[r];
    ss = half_sum(ss);
    const float rs = rsqrtf(ss * (1.f / 64.f) + NORM_EPS);
    bf16* op = MIX + (rowbase + qw + j) * D_MODEL + h * 64 + 4 * hi;
    const float* gp = sbg + h * 64 + 4 * hi;
#pragma unroll
    for (int g = 0; g < 4; ++g) {
        const f32x4 g0 = *(const f32x4*)(gp + 8 * g), g1 = *(const f32x4*)(gp + 32 + 8 * g);
        u32x2 w0, w1;
        w0.x = pk2(o0[4 * g] * rs * g0.x, o0[4 * g + 1] * rs * g0.y); w0.y = pk2(o0[4 * g + 2] * rs * g0.z, o0[4 * g + 3] * rs * g0.w);
        w1.x = pk2(o1[4 * g] * rs * g1.x, o1[4 * g + 1] * rs * g1.y); w1.y = pk2(o1[4 * g + 2] * rs * g1.z, o1[4 * g + 3] * rs * g1.w);
        *(u32x2*)(op + 8 * g) = w0; *(u32x2*)(op + 32 + 8 * g) = w1;
    }
}

constexpr int XA_KP = 136, XA_VP = 136;
__device__ __forceinline__ void xatt_stage(LAS unsigned char* lds, const bf16* KVm, int b, int mh, const int tid) {
    LAS bf16* Ks = (LAS bf16*)lds;
    LAS bf16* Vt = (LAS bf16*)(lds + 256 * XA_KP * 2);
    const bf16* base = KVm + (size_t)b * MEM_LEN * D_MODEL + mh * 128;
    u32x4 kv[8];
#pragma unroll
    for (int i = 0; i < 8; ++i) { const int p = tid + 512 * i, key = p >> 4, dg = p & 15; kv[i] = *(const u32x4*)(base + (size_t)key * D_MODEL + 8 * dg); }
#pragma unroll
    for (int i = 0; i < 8; ++i) { const int p = tid + 512 * i, key = p >> 4, dg = p & 15; *(LAS u32x4*)(Ks + key * XA_KP + 8 * dg) = kv[i]; }
#pragma unroll
    for (int i = 0; i < 8; ++i) { const int p = tid + 512 * i, key = p >> 4, dg = p & 15; kv[i] = *(const u32x4*)(base + (size_t)key * D_MODEL + 512 + 8 * dg); }
#pragma unroll
    for (int i = 0; i < 8; ++i) { const int p = tid + 512 * i, key = p >> 4, dg = p & 15; *(LAS u32x4*)(Vt + key * XA_VP + 8 * dg) = kv[i]; }
}
__device__ __forceinline__ void xatt_unit(LAS unsigned char* lds, const bf16* Qm, bf16* Om, int b, int mh, int qb, const int tid) {
    const int wave = tid >> 6, lane = tid & 63, j = lane & 31, hi = lane >> 5;
    LAS bf16* Ks = (LAS bf16*)lds;
    LAS bf16* Vt = (LAS bf16*)(lds + 256 * XA_KP * 2);
    const int qw = 256 * qb + 32 * wave;
    const size_t qrow = (size_t)b * SEQ + qw + j;
    bf16x8 qf[8];
    { const bf16* qp = Qm + qrow * MEM_W + mh * 128 + 8 * hi;
#pragma unroll
      for (int ks = 0; ks < 8; ++ks) qf[ks] = *(const bf16x8*)(qp + 16 * ks); }
    f32x16 o[4];
#pragma unroll
    for (int t = 0; t < 4; ++t)
#pragma unroll
        for (int r = 0; r < 16; ++r) o[t][r] = 0.f;
    float mrun = -1e30f, lsum = 0.f;
    const float scale = 0.08838834764831845f;
#pragma unroll 1
    for (int sub = 0; sub < 8; ++sub) {
        f32x16 acc;
#pragma unroll
        for (int r = 0; r < 16; ++r) acc[r] = 0.f;
#pragma unroll
        for (int ks = 0; ks < 8; ++ks) { const bf16x8 a = *(const LAS bf16x8*)(Ks + (32 * sub + j) * XA_KP + 16 * ks + 8 * hi); acc = MFMA32(a, qf[ks], acc); }
        float mx = -1e30f;
#pragma unroll
        for (int r = 0; r < 16; ++r) { acc[r] *= scale; mx = fmaxf(mx, acc[r]); }
        mx = half_max(mx);
        const float mnew = fmaxf(mrun, mx), corr = __expf(mrun - mnew);
        mrun = mnew; lsum *= corr;
        float p[16];
#pragma unroll
        for (int r = 0; r < 16; ++r) { p[r] = __expf(acc[r] - mnew); lsum += p[r]; }
#pragma unroll
        for (int t = 0; t < 4; ++t)
#pragma unroll
            for (int r = 0; r < 16; ++r) o[t][r] *= corr;
        u32x4 p0, p1;
        p0.x = pk2(p[0], p[1]); p0.y = pk2(p[2], p[3]); p0.z = pk2(p[4], p[5]); p0.w = pk2(p[6], p[7]);
        p1.x = pk2(p[8], p[9]); p1.y = pk2(p[10], p[11]); p1.z = pk2(p[12], p[13]); p1.w = pk2(p[14], p[15]);
        const bf16x8 pa0 = __builtin_bit_cast(bf16x8, p0), pa1 = __builtin_bit_cast(bf16x8, p1);
#pragma unroll
        for (int s = 0; s < 2; ++s) {
            const bf16x8 pb = s ? pa1 : pa0;
#pragma unroll
            for (int t = 0; t < 4; ++t) {
                const LAS bf16* vp = Vt + (32 * sub + 16 * s + 4 * hi + ((lane & 15) >> 2)) * XA_VP + 32 * t + 16 * ((lane >> 4) & 1) + 4 * (lane & 3);
                const s16x4 lo = lds_tr16(vp), hh = lds_tr16(vp + 8 * XA_VP); const bf16x8 va = __builtin_shufflevector(lo, hh, 0, 1, 2, 3, 4, 5, 6, 7);
                o[t] = MFMA32(va, pb, o[t]);
            }
        }
    }
    lsum = half_sum(lsum);
    const float inv = 1.f / lsum;
    bf16* op = Om + qrow * MEM_W + mh * 128 + 4 * hi;
#pragma unroll
    for (int t = 0; t < 4; ++t)
#pragma unroll
        for (int g = 0; g < 4; ++g) { u32x2 w; w.x = pk2(o[t][4 * g] * inv, o[t][4 * g + 1] * inv); w.y = pk2(o[t][4 * g + 2] * inv, o[t][4 * g + 3] * inv); *(u32x2*)(op + 32 * t + 8 * g) = w; }
}

constexpr int RW_P = 68;
constexpr int RW_ARR = 32 * RW_P * 4;
constexpr int RW_XWP = 72, RW_XGP = 168;
__device__ __forceinline__ void rw_lerp8(const u32x4 cu, const u32x4 pr, const LAS float* mu, float (&v)[8]) {
    const f32x4 m0 = *(const LAS f32x4*)mu, m1 = *(const LAS f32x4*)(mu + 4);
    float x, p;
    x = bflo(cu.x); p = bflo(pr.x); v[0] = x + (p - x) * m0.x;  x = bfhi(cu.x); p = bfhi(pr.x); v[1] = x + (p - x) * m0.y;
    x = bflo(cu.y); p = bflo(pr.y); v[2] = x + (p - x) * m0.z;  x = bfhi(cu.y); p = bfhi(pr.y); v[3] = x + (p - x) * m0.w;
    x = bflo(cu.z); p = bflo(pr.z); v[4] = x + (p - x) * m1.x;  x = bfhi(cu.z); p = bfhi(pr.z); v[5] = x + (p - x) * m1.y;
    x = bflo(cu.w); p = bflo(pr.w); v[6] = x + (p - x) * m1.z;  x = bfhi(cu.w); p = bfhi(pr.w); v[7] = x + (p - x) * m1.w;
}
__device__ __forceinline__ void rw_st_f32(LAS float* dst, const float (&v)[8]) { *(LAS f32x4*)dst = (f32x4){v[0], v[1], v[2], v[3]}; *(LAS f32x4*)(dst + 4) = (f32x4){v[4], v[5], v[6], v[7]}; }
__device__ __forceinline__ void rw_st_bf16(LAS bf16* dst, const float (&v)[8]) { u32x4 w; w.x = pk2(v[0], v[1]); w.y = pk2(v[2], v[3]); w.z = pk2(v[4], v[5]); w.w = pk2(v[6], v[7]); *(LAS u32x4*)dst = w; }
__device__ __forceinline__ void rwkv_head(LAS unsigned char* lds, const Args& a, const bf16* U, bf16* MIX, int b, int h, const int tid) {
    const int wave = __builtin_amdgcn_readfirstlane(tid >> 6), lane = tid & 63;
    LAS float* R = (LAS float*)(lds + 0 * RW_ARR); LAS float* Wd = (LAS float*)(lds + 1 * RW_ARR); LAS float* Kk = (LAS float*)(lds + 2 * RW_ARR); LAS float* Vv = (LAS float*)(lds + 3 * RW_ARR);
    LAS float* Aa = (LAS float*)(lds + 4 * RW_ARR); LAS float* Bb = (LAS float*)(lds + 5 * RW_ARR); LAS float* Gg = (LAS float*)(lds + 6 * RW_ARR); LAS float* Yy = (LAS float*)(lds + 7 * RW_ARR);
    LAS float* RK = (LAS float*)(lds + 8 * RW_ARR);
    LAS float* MU = (LAS float*)(lds + 8 * RW_ARR + 256);
    LAS bf16* XW = (LAS bf16*)(lds + 8 * RW_ARR + 256 + 2048); LAS bf16* XA = XW + 32 * RW_XWP; LAS bf16* XG = XA + 32 * RW_XWP;
    const int tok = tid >> 4, l16 = tid & 15, lo8 = (l16 < 8), l7 = l16 & 7;
    const int col0 = lo8 ? 64 * h + 8 * l7 : 512 + 64 * h + 8 * l7;
    const int col1 = lo8 ? 1024 + 64 * h + 8 * l7 : 1600 + 8 * l7;
    const int col2 = lo8 ? 1536 + 8 * l7 : 1664 + 8 * l7;
    const int col3 = 1728 + 8 * l16;
    __syncthreads();
    if (tid < 64) { const int i = tid >> 4, q = tid & 15; const bool q8 = q < 8; const int q7 = q & 7;
        const int cc = (i == 0) ? (q8 ? 64 * h + 8 * q7 : 512 + 64 * h + 8 * q7) : (i == 1) ? (q8 ? 1024 + 64 * h + 8 * q7 : 1600 + 8 * q7) : (i == 2) ? (q8 ? 1536 + 8 * q7 : 1664 + 8 * q7) : (q < 12 ? 1728 + 8 * q : 1728);
        const float* mu = a.in[I_MU] + cc;
#pragma unroll
        for (int e = 0; e < 8; ++e) MU[(i * 16 + q) * 8 + e] = mu[e]; }
    const int c4 = 4 * l16, gc = 64 * h + c4;
    const f32x4 kkw = *(const f32x4*)(a.in[I_KK] + gc), kaw = *(const f32x4*)(a.in[I_KA] + gc), rkw = *(const f32x4*)(a.in[I_RK] + gc);
    const f32x4 lg = *(const f32x4*)(a.in[I_LNG] + gc), lb = *(const f32x4*)(a.in[I_LNB] + gc);
    const int lkind = (wave < 2 || (wave >= 4 && wave < 6)) ? 0 : (wave < 4 ? 1 : 2), lnt = wave & 1, lj = lane & 31, lhi = lane >> 5;
    const bool lactive = true; const bool lupper = (wave >= 4);
    const int lnks = (lkind == 2) ? 10 : 4;
    const int lgcol = 64 * h + 32 * lnt + lj;
    bf16x8 wf[10];
    float lbias = 0.f;
    if (lactive) {
        const bf16* wb = (lkind == 0 ? (const bf16*)(a.ws + WS_LW2) + (size_t)lgcol * 64 : lkind == 1 ? (const bf16*)(a.ws + WS_LA2) + (size_t)lgcol * 64 : (const bf16*)(a.ws + WS_LG2) + (size_t)lgcol * 160) + 8 * lhi;
#pragma unroll
        for (int ks = 0; ks < 10; ++ks) if (ks < lnks) wf[ks] = *(const bf16x8*)(wb + 16 * ks);
        if (lkind == 0) lbias = a.in[I_W0][lgcol]; else if (lkind == 1) lbias = a.in[I_A0][lgcol];
    }
    const int srow = 8 * wave + 2 * (lane >> 4), kl = lane & 15;
    f32x4 pvv = {0.f, 0.f, 0.f, 0.f}, pgg = {0.f, 0.f, 0.f, 0.f}; float prk = 0.f;
    float S00 = 0.f, S01 = 0.f, S02 = 0.f, S03 = 0.f, S10 = 0.f, S11 = 0.f, S12 = 0.f, S13 = 0.f;
    const bf16* ubase = U + ((size_t)b * SEQ + tok) * LDU + RW_OFF;
    u32x4 cu0, cu1, cu2, cu3, pr0, pr1, pr2, pr3;
    const u32x4 z4 = (u32x4){0u, 0u, 0u, 0u};
    cu0 = *(const u32x4*)(ubase + col0); cu1 = *(const u32x4*)(ubase + col1); cu2 = *(const u32x4*)(ubase + col2); cu3 = (l16 < 12) ? *(const u32x4*)(ubase + col3) : z4;
    pr0 = z4; pr1 = z4; pr2 = z4; pr3 = z4;
    if (tok > 0) { pr0 = *(const u32x4*)(ubase - LDU + col0); pr1 = *(const u32x4*)(ubase - LDU + col1); pr2 = *(const u32x4*)(ubase - LDU + col2); if (l16 < 12) pr3 = *(const u32x4*)(ubase - LDU + col3); }
    __syncthreads();
    for (int c = 0; c < SEQ / 32; ++c) {
        const int t0 = 32 * c;
        {
            float v[8];
            rw_lerp8(cu0, pr0, MU + (0 * 16 + l16) * 8, v); rw_st_f32((lo8 ? R : Kk) + tok * RW_P + 8 * l7, v);
            rw_lerp8(cu1, pr1, MU + (1 * 16 + l16) * 8, v);
            if (lo8) rw_st_f32(Vv + tok * RW_P + 8 * l7, v); else rw_st_bf16(XA + tok * RW_XWP + 8 * l7, v);
            rw_lerp8(cu2, pr2, MU + (2 * 16 + l16) * 8, v);
            { const float s0 = lo8 ? -2.f : -1.f, s1 = lo8 ? 2.f : 1.f, s2 = lo8 ? -1.f : 0.f;
#pragma unroll
              for (int i = 0; i < 8; ++i) { const float xx = fminf(fmaxf(v[i], -30.f), 30.f); v[i] = fmaf(s1, __builtin_amdgcn_rcpf(1.f + __expf(s0 * xx)), s2); }
              rw_st_bf16((lo8 ? XW + tok * RW_XWP : XG + tok * RW_XGP) + 8 * l7, v); }
            if (l16 < 12) {
                rw_lerp8(cu3, pr3, MU + (3 * 16 + l16) * 8, v);
#pragma unroll
                for (int i = 0; i < 8; ++i) v[i] = __builtin_amdgcn_rcpf(1.f + __expf(-v[i]));
                rw_st_bf16(XG + tok * RW_XGP + 64 + 8 * l16, v); }
        }
        LDS_BARRIER();
        if (c + 1 < SEQ / 32) {
            const bf16* ub = ubase + (size_t)(t0 + 32) * LDU;
            cu0 = *(const u32x4*)(ub + col0); cu1 = *(const u32x4*)(ub + col1); cu2 = *(const u32x4*)(ub + col2); if (l16 < 12) cu3 = *(const u32x4*)(ub + col3);
            pr0 = *(const u32x4*)(ub - LDU + col0); pr1 = *(const u32x4*)(ub - LDU + col1); pr2 = *(const u32x4*)(ub - LDU + col2); if (l16 < 12) pr3 = *(const u32x4*)(ub - LDU + col3);
        }
        if (lactive) {
            const LAS bf16* xa = (lkind == 0 ? XW + lj * RW_XWP : lkind == 1 ? XA + lj * RW_XWP : XG + lj * RW_XGP) + 8 * lhi;
            f32x16 acc;
#pragma unroll
            for (int r = 0; r < 16; ++r) acc[r] = 0.f;
#pragma unroll
            for (int ks = 0; ks < 10; ++ks) if (ks < lnks) { const bf16x8 av = *(const LAS bf16x8*)(xa + 16 * ks); acc = MFMA32(av, wf[ks], acc); }
            const int col = 32 * lnt + lj;
            if (lkind == 0) {
#pragma unroll
                for (int r = 0; r < 16; ++r) if ((r >= 8) == lupper) { const int tk = 8 * (r >> 2) + 4 * lhi + (r & 3); const float x = lbias + acc[r];
                    Wd[tk * RW_P + col] = __expf(-0.6065306597126334f * __builtin_amdgcn_rcpf(1.f + __expf(-x))); }
            } else if (lkind == 1) {
#pragma unroll
                for (int r = 0; r < 16; ++r) { const int tk = 8 * (r >> 2) + 4 * lhi + (r & 3); Bb[tk * RW_P + col] = __builtin_amdgcn_rcpf(1.f + __expf(-(lbias + acc[r]))); }
            } else {
#pragma unroll
                for (int r = 0; r < 16; ++r) { const int tk = 8 * (r >> 2) + 4 * lhi + (r & 3); Gg[tk * RW_P + col] = acc[r]; }
            }
        }
        LDS_BARRIER();
        {
            if (c > 0) {
                f32x4 y; { const LAS float* yq = (const LAS float*)(lds + 94208) + (tok * 32 + 2 * l16) * 8; const f32x4 v0 = *(const LAS f32x4*)yq, v1 = *(const LAS f32x4*)(yq + 4), v2 = *(const LAS f32x4*)(yq + 8), v3 = *(const LAS f32x4*)(yq + 12);
                  y = (f32x4){(v0.x + v0.z) + (v1.x + v1.z), (v0.y + v0.w) + (v1.y + v1.w), (v2.x + v2.z) + (v3.x + v3.z), (v2.y + v2.w) + (v3.y + v3.w)}; }
                const float mean = red16((y.x + y.y) + (y.z + y.w)) * (1.f / 64.f);
                const f32x4 d = y - mean;
                const float var = red16((d.x * d.x + d.y * d.y) + (d.z * d.z + d.w * d.w)) * (1.f / 64.f);
                const float rs = rsqrtf(var + LNX_EPS);
                const f32x4 o = (d * rs * lg + lb + prk * pvv) * pgg;
                u32x2 w; w.x = pk2(o.x, o.y); w.y = pk2(o.z, o.w);
                *(u32x2*)(MIX + ((size_t)b * SEQ + t0 - 32 + tok) * D_MODEL + 512 + gc) = w;
            }
            const f32x4 kr = *(LAS f32x4*)(Kk + tok * RW_P + c4), al = *(LAS f32x4*)(Bb + tok * RW_P + c4), rr = *(LAS f32x4*)(R + tok * RW_P + c4);
            pvv = *(LAS f32x4*)(Vv + tok * RW_P + c4); pgg = *(LAS f32x4*)(Gg + tok * RW_P + c4);
            f32x4 kkv = kr * kkw;
            const float ssq = red16((kkv.x * kkv.x + kkv.y * kkv.y) + (kkv.z * kkv.z + kkv.w * kkv.w));
            const float inv = 1.f / fmaxf(sqrtf(ssq), 1e-12f);
            kkv = kkv * inv;
            const f32x4 km = kr * (1.f + (al - 1.f) * kaw);
            *(LAS f32x4*)(Aa + tok * RW_P + c4) = -kkv;
            *(LAS f32x4*)(Bb + tok * RW_P + c4) = kkv * al;
            *(LAS f32x4*)(Kk + tok * RW_P + c4) = km;
            const f32x4 pr = rr * km * rkw;
            prk = red16((pr.x + pr.y) + (pr.z + pr.w));
        }
        LDS_BARRIER();
        {
            const unsigned ak = (unsigned)(size_t)lds + 16u * kl, av = (unsigned)(size_t)lds + 3u * RW_ARR + 4u * srow;
            const unsigned yaddr = (unsigned)(size_t)(lds + 94208 + ((srow >> 1) * 4 + (kl >> 2)) * 8);
            const unsigned ystep = 1024u;
#define RW_LDS_STEP(tt) do { const unsigned _a = ak + (unsigned)((tt) * RW_P * 4), _v = av + (unsigned)((tt) * RW_P * 4); \
                asm volatile("ds_read_b128 %0, %1 offset:34816" : "=v"(na) : "v"(_a)); asm volatile("ds_read_b128 %0, %1 offset:8704" : "=v"(nw) : "v"(_a)); \
                asm volatile("ds_read_b128 %0, %1 offset:43520" : "=v"(nb) : "v"(_a)); asm volatile("ds_read_b128 %0, %1 offset:17408" : "=v"(nk) : "v"(_a)); \
                asm volatile("ds_read_b128 %0, %1" : "=v"(nr) : "v"(_a)); asm volatile("ds_read_b64 %0, %1" : "=v"(nv) : "v"(_v)); } while (0)
            f32x4 na, nw, nb, nk, nr; f32x2 nv;
            RW_LDS_STEP(0);
            asm volatile("s_waitcnt lgkmcnt(0)" : "+v"(na), "+v"(nw), "+v"(nb), "+v"(nk), "+v"(nr), "+v"(nv));
#pragma unroll 4
            for (int t = 0; t < 32; ++t) {
                const f32x4 a4 = na, w4 = nw, b4 = nb, k4 = nk, r4 = nr; const f32x2 v2 = nv;
                RW_LDS_STEP((t + 1) & 31);
                float sa0 = fmaf(S03, a4.w, fmaf(S02, a4.z, fmaf(S01, a4.y, S00 * a4.x)));
                float sa1 = fmaf(S13, a4.w, fmaf(S12, a4.z, fmaf(S11, a4.y, S10 * a4.x)));
                sa0 = red16(sa0); sa1 = red16(sa1);
                S00 = fmaf(v2.x, k4.x, fmaf(sa0, b4.x, S00 * w4.x)); S01 = fmaf(v2.x, k4.y, fmaf(sa0, b4.y, S01 * w4.y));
                S02 = fmaf(v2.x, k4.z, fmaf(sa0, b4.z, S02 * w4.z)); S03 = fmaf(v2.x, k4.w, fmaf(sa0, b4.w, S03 * w4.w));
                S10 = fmaf(v2.y, k4.x, fmaf(sa1, b4.x, S10 * w4.x)); S11 = fmaf(v2.y, k4.y, fmaf(sa1, b4.y, S11 * w4.y));
                S12 = fmaf(v2.y, k4.z, fmaf(sa1, b4.z, S12 * w4.z)); S13 = fmaf(v2.y, k4.w, fmaf(sa1, b4.w, S13 * w4.w));
                float y0 = fmaf(S03, r4.w, fmaf(S02, r4.z, fmaf(S01, r4.y, S00 * r4.x)));
                float y1 = fmaf(S13, r4.w, fmaf(S12, r4.z, fmaf(S11, r4.y, S10 * r4.x)));
                asm volatile("" : "+v"(y0), "+v"(y1));
                y0 += dppf<0xB1>(y0); y1 += dppf<0xB1>(y1); y0 += dppf<0x4E>(y0); y1 += dppf<0x4E>(y1);
                asm volatile("" : "+v"(y0), "+v"(y1));
                { const f32x2 yv = {y0, y1}; asm volatile("ds_write_b64 %0, %1" :: "v"(yaddr + (unsigned)(t * ystep)), "v"(yv)); }
                asm volatile("s_waitcnt lgkmcnt(0)" : "+v"(na), "+v"(nw), "+v"(nb), "+v"(nk), "+v"(nr), "+v"(nv));
            }
        }
        LDS_BARRIER();
    }
    {
        f32x4 y; { const LAS float* yq = (const LAS float*)(lds + 94208) + (tok * 32 + 2 * l16) * 8; const f32x4 v0 = *(const LAS f32x4*)yq, v1 = *(const LAS f32x4*)(yq + 4), v2 = *(const LAS f32x4*)(yq + 8), v3 = *(const LAS f32x4*)(yq + 12);
                  y = (f32x4){(v0.x + v0.z) + (v1.x + v1.z), (v0.y + v0.w) + (v1.y + v1.w), (v2.x + v2.z) + (v3.x + v3.z), (v2.y + v2.w) + (v3.y + v3.w)}; }
        const float mean = red16((y.x + y.y) + (y.z + y.w)) * (1.f / 64.f);
        const f32x4 d = y - mean;
        const float var = red16((d.x * d.x + d.y * d.y) + (d.z * d.z + d.w * d.w)) * (1.f / 64.f);
        const float rs = rsqrtf(var + LNX_EPS);
        const f32x4 o = (d * rs * lg + lb + prk * pvv) * pgg;
        u32x2 w; w.x = pk2(o.x, o.y); w.y = pk2(o.z, o.w);
        *(u32x2*)(MIX + ((size_t)b * SEQ + SEQ - 32 + tok) * D_MODEL + 512 + gc) = w;
    }
    __syncthreads();
}

#define XB_TMO      128
#define XB_XCNT(j)  (256  + 64 * (j))
#define XB_XSUB(j)  (1280 + 64 * (j))
#define XB_XGEN(j)  (2304 + 64 * (j))
#define XB_TOP      3328
#define XB_TOPGEN   3392
#define XCD_BAR_WORDS 3456
#define XB_SPIN_CAP (1u << 18)

__device__ __forceinline__ unsigned xb_ld(unsigned* p)              { return __hip_atomic_load(p, __ATOMIC_RELAXED, __HIP_MEMORY_SCOPE_AGENT); }
__device__ __forceinline__ unsigned xb_add(unsigned* p, unsigned v) { return __hip_atomic_fetch_add(p, v, __ATOMIC_RELAXED, __HIP_MEMORY_SCOPE_AGENT); }
__device__ __forceinline__ unsigned xb_xcc_id() { return (unsigned)__builtin_amdgcn_s_getreg((3 << 11) | 20) & 0xFu; }
#define XB_SPIN(cond, bar) do { unsigned _sp = 0; while (cond) { __builtin_amdgcn_s_sleep(1); \
    if ((++_sp & 255u) == 0u) { if (xb_ld(&(bar)[XB_TMO])) break; if (_sp > XB_SPIN_CAP) { atomicAdd(&(bar)[XB_TMO], 1u); break; } } } } while (0)

struct XcdBarrier {
    unsigned* bar; unsigned x;
    volatile LAS unsigned* st;
};

__device__ __forceinline__ XcdBarrier xcd_barrier_post(unsigned* bar, volatile LAS unsigned* st) {
    XcdBarrier b; b.bar = bar; b.x = xb_xcc_id(); b.st = st;
    if (threadIdx.x == 0) (void)xb_add(&bar[XB_XCNT(b.x)], 1u);
    return b;
}
__device__ __forceinline__ void xcd_barrier_complete(unsigned* bar, unsigned x, unsigned& nloc, unsigned& nx) {
    const unsigned G = gridDim.x * gridDim.y * gridDim.z;
    unsigned sum, cnt, mine, sp = 0u;
    for (;;) {
        sum = 0u; cnt = 0u; mine = 0u;
#pragma unroll
        for (unsigned j = 0; j < 16; ++j) { const unsigned c = xb_ld(&bar[XB_XCNT(j)]); sum += c; cnt += (c > 0u) ? 1u : 0u; mine = (j == x) ? c : mine; }
        if (sum == G) break;
        __builtin_amdgcn_s_sleep(1);
        if ((++sp & 255u) == 0u) { if (xb_ld(&bar[XB_TMO])) break; if (sp > XB_SPIN_CAP) { atomicAdd(&bar[XB_TMO], 1u); break; } }
    }
    nloc = mine > 0u ? mine : 1u; nx = cnt > 0u ? cnt : 1u;
}

__device__ __forceinline__ void xcd_barrier(const XcdBarrier& b) {
    asm volatile("s_waitcnt vmcnt(0)" ::: "memory");
    __syncthreads();
    if (threadIdx.x == 0) {
        unsigned* bar = b.bar;
        __builtin_amdgcn_s_waitcnt(0);
        unsigned nloc = b.st[0], nx = b.st[1];
        if (nloc == 0u) { xcd_barrier_complete(bar, b.x, nloc, nx); b.st[0] = nloc; b.st[1] = nx; }
        const unsigned old = xb_add(&bar[XB_XSUB(b.x)], 1u);
        const unsigned gen = old / nloc;
        if (old + 1u == (gen + 1u) * nloc) {
            __builtin_amdgcn_fence(__ATOMIC_RELEASE, "agent");
            asm volatile("s_waitcnt vmcnt(0)" ::: "memory");
            const unsigned og = xb_add(&bar[XB_TOP], 1u);
            const unsigned tg = og / nx;
            if (og + 1u == (tg + 1u) * nx) xb_add(&bar[XB_TOPGEN], 1u);
            else XB_SPIN(xb_ld(&bar[XB_TOPGEN]) == tg, bar);
            __builtin_amdgcn_fence(__ATOMIC_ACQUIRE, "agent");
            xb_add(&bar[XB_XGEN(b.x)], 1u);
            asm volatile("s_waitcnt vmcnt(0)" ::: "memory");
        } else {
            XB_SPIN(xb_ld(&bar[XB_XGEN(b.x)]) == gen, bar);
            __builtin_amdgcn_fence(__ATOMIC_ACQUIRE, "agent");
            asm volatile("s_waitcnt vmcnt(0)" ::: "memory");
        }
    }
    __syncthreads();
}

__device__ __forceinline__ void sub_barrier(unsigned* ctr, unsigned n) {
    asm volatile("s_waitcnt vmcnt(0)" ::: "memory");
    __syncthreads();
    if (threadIdx.x == 0) {
        __builtin_amdgcn_fence(__ATOMIC_RELEASE, "agent");
        asm volatile("s_waitcnt vmcnt(0)" ::: "memory");
        (void)__hip_atomic_fetch_add(ctr, 1u, __ATOMIC_RELAXED, __HIP_MEMORY_SCOPE_AGENT);
        unsigned sp = 0u;
        while (__hip_atomic_load(ctr, __ATOMIC_RELAXED, __HIP_MEMORY_SCOPE_AGENT) < n) { __builtin_amdgcn_s_sleep(2); if (++sp > (1u << 22)) break; }
        __builtin_amdgcn_fence(__ATOMIC_ACQUIRE, "agent");
        asm volatile("s_waitcnt vmcnt(0)" ::: "memory");
    }
    __syncthreads();
}
constexpr int MIXA_C0 = 1536;
constexpr int SUBBAR_WORD = 8192;
constexpr int N_PHASES = 16;
constexpr int XB_LDS_OFF = LDS_BYTES - 64, XB_WS_WORD = 4096;
__global__ void __launch_bounds__(NTHREADS, 2) mega_fwd(Args args) {
    extern __shared__ __attribute__((aligned(16))) unsigned char lds_raw[];
    LAS unsigned char* lds0 = (LAS unsigned char*)lds_raw;
    const Args* ap0 = (const Args*)__builtin_amdgcn_kernarg_segment_ptr();
    const int ph_lo = ap0->ph_lo, ph_hi = ap0->ph_hi;
    if (ph_hi - ph_lo > 1) {
        volatile LAS unsigned* bst = (volatile LAS unsigned*)(lds0 + XB_LDS_OFF);
        if (threadIdx.x < 2) bst[threadIdx.x] = 0u;
        __syncthreads();
        (void)xcd_barrier_post((unsigned*)(ap0->ws) + XB_WS_WORD, bst);
    }
    for (int ph = ph_lo; ph < ph_hi; ++ph) {
        const Args* ap = ap0; asm volatile("" : "+s"(ap));
        const Args& A = *ap;
        int tid = threadIdx.x; asm volatile("" : "+v"(tid));
        int G = gridDim.x, bid = blockIdx.x; asm volatile("" : "+s"(G), "+s"(bid));
        LAS unsigned char* lds = lds0; asm volatile("" : "+s"(lds));
        const int lane = tid & 63, wave = __builtin_amdgcn_readfirstlane(tid >> 6);
        const int gw = bid * NWAVES + wave, NGW = G * NWAVES;
        unsigned char* ws = A.ws;
        bool is_gemm = false; pg8::Gemm g{nullptr, nullptr, 0, 0, 0}; pg8::EpiU E{nullptr, 0, 0}; int gG = G, gc = bid;
        switch (ph) {
        case 0: prologue<0>(A, lds, gw, NGW, wave, lane); break;
        case 1: g = pg8::Gemm{(const bf16*)(ws + WS_XN), (const bf16*)(ws + WS_W1IN), M_TOK, 2 * D_FF, D_MODEL}; E = pg8::EpiU{(bf16*)(ws + WS_HU), D_FF, 1}; is_gemm = true; break;
        case 2: g = pg8::Gemm{(const bf16*)(ws + WS_HU), (const bf16*)(ws + WS_W1OUT), M_TOK, D_MODEL, D_FF}; E = pg8::EpiU{(bf16*)(ws + WS_Y), D_MODEL, 0}; is_gemm = true; break;
        case 3: norm_pass<false, true>((const bf16*)(ws + WS_Y), A.in[I_X], ws + WS_HB, 0.5f, A.in[I_F1POST], A.in[I_MIXPRE], (bf16*)(ws + WS_XN), gw, NGW, lane); break;
        case 4: g = pg8::Gemm{(const bf16*)(ws + WS_XN), (const bf16*)(ws + WS_WMIXIN) + (size_t)MIXA_C0 * D_MODEL, M_TOK, LDU - MIXA_C0, D_MODEL}; E = pg8::EpiU{(bf16*)(ws + WS_HU) + MIXA_C0, LDU, 0}; is_gemm = true; break;
        case 5: { const int nR = (G >= 256) ? 128 : (G / 2 > 0 ? G / 2 : 1);
                  if (bid >= nR) { g = pg8::Gemm{(const bf16*)(ws + WS_XN), (const bf16*)(ws + WS_WMIXIN), M_TOK, MIXA_C0, D_MODEL}; E = pg8::EpiU{(bf16*)(ws + WS_HU), LDU, 0}; is_gemm = true; gG = G - nR; gc = bid - nR; } } break;
        case 6: {
            const bf16* HU = (const bf16*)(ws + WS_HU); bf16* XN = (bf16*)(ws + WS_Y);
            const int nR = (G >= 256) ? 128 : (G / 2 > 0 ? G / 2 : 1);
            if (bid < nR) { for (int hd = bid; hd < BATCH * 8; hd += nR) rwkv_head(lds, A, HU, XN, hd >> 3, hd & 7, tid); }
            else { if (ph_hi - ph_lo > 1) sub_barrier((unsigned*)(ws) + SUBBAR_WORD, (unsigned)(G - nR));
                   for (int u = bid - nR; u < BATCH * 8 * 8; u += G - nR) { const int bh = u & 127, qb = 7 - (u >> 7); sb_unit(lds, HU, XN, A.in[I_SBG], bh >> 3, bh & 7, qb, tid); }
                   __syncthreads();
                   { const int sb = bid - nR, nsb = G - nR;
                     if (nsb == 128) { if (sb < 64) prologue<1>(A, lds, sb * NWAVES + wave, 2048, wave, lane);
                                       else { for (int k = 0; k < 3; ++k) { prologue<1>(A, lds, 512 + ((sb - 64) * NWAVES + wave) * 3 + k, 2048, wave, lane); } } }
                     else prologue<1>(A, lds, sb * NWAVES + wave, nsb * NWAVES, wave, lane); }
                   __syncthreads();
                   g = pg8::Gemm{(const bf16*)(ws + WS_MEMN), (const bf16*)(ws + WS_WKV), M_MEM, D_MODEL, D_MODEL}; E = pg8::EpiU{(bf16*)(ws + WS_KVM), D_MODEL, 0}; is_gemm = true; gG = G - nR; gc = bid - nR; }
        } break;
        case 7: g = pg8::Gemm{(const bf16*)(ws + WS_Y), (const bf16*)(ws + WS_WMIXOUT), M_TOK, D_MODEL, D_MODEL}; E = pg8::EpiU{(bf16*)(ws + WS_XN), D_MODEL, 0}; is_gemm = true; break;
        case 8: norm_pass<true, true>((const bf16*)(ws + WS_XN), ws + WS_HB, ws + WS_HB, 1.0f, A.in[I_MIXPOST], A.in[I_MEMPRE], (bf16*)(ws + WS_XN), gw, NGW, lane); break;
        case 9: g = pg8::Gemm{(const bf16*)(ws + WS_XN), (const bf16*)(ws + WS_WQ), M_TOK, MEM_W, D_MODEL}; E = pg8::EpiU{(bf16*)(ws + WS_QM), MEM_W, 0}; is_gemm = true; break;
        case 10: for (int pu = bid; pu < BATCH * 4 * 4; pu += G) { const int bm = pu >> 2, q0 = pu & 3, b = bm >> 2, mh = bm & 3;
                     __syncthreads(); xatt_stage(lds, (const bf16*)(ws + WS_KVM), b, mh, tid); __syncthreads();
                     xatt_unit(lds, (const bf16*)(ws + WS_QM), (bf16*)(ws + WS_OM), b, mh, q0, tid); xatt_unit(lds, (const bf16*)(ws + WS_QM), (bf16*)(ws + WS_OM), b, mh, q0 + 4, tid); } break;
        case 11: g = pg8::Gemm{(const bf16*)(ws + WS_OM), (const bf16*)(ws + WS_WO), M_TOK, D_MODEL, MEM_W}; E = pg8::EpiU{(bf16*)(ws + WS_Y), D_MODEL, 0}; is_gemm = true; break;
        case 12: norm_pass<true, true>((const bf16*)(ws + WS_Y), ws + WS_HB, ws + WS_HB, 1.0f, A.in[I_MEMPOST], A.in[I_F2PRE], (bf16*)(ws + WS_XN), gw, NGW, lane); break;
        case 13: g = pg8::Gemm{(const bf16*)(ws + WS_XN), (const bf16*)(ws + WS_W2IN), M_TOK, 2 * D_FF, D_MODEL}; E = pg8::EpiU{(bf16*)(ws + WS_HU), D_FF, 1}; is_gemm = true; break;
        case 14: g = pg8::Gemm{(const bf16*)(ws + WS_HU), (const bf16*)(ws + WS_W2OUT), M_TOK, D_MODEL, D_FF}; E = pg8::EpiU{(bf16*)(ws + WS_Y), D_MODEL, 0}; is_gemm = true; break;
        case 15: norm_pass<true, false>((const bf16*)(ws + WS_Y), ws + WS_HB, A.out, 0.5f, A.in[I_F2POST], nullptr, nullptr, gw, NGW, lane); break;
        default: break;
        }
        if (is_gemm) { pg8::StaticOrder S; S.init(g.M, g.N, gG, gc); pg8::gemm_phase<pg8::EpiU, pg8::StaticOrder, true, true>(lds, g, S, E, tid); }
        if (ph + 1 < ph_hi && ph != 5) {
            if (ph_hi > N_PHASES) { __syncthreads(); cg::this_grid().sync(); }
            else { XcdBarrier xb; xb.bar = (unsigned*)(A.ws) + XB_WS_WORD; xb.x = xb_xcc_id(); xb.st = (volatile LAS unsigned*)(lds + XB_LDS_OFF); xcd_barrier(xb); }
        }
    }
}

#ifndef MK_ONE_LAUNCH
#define MK_ONE_LAUNCH 1
#endif
extern "C" void kernel_launch(void* const* d_in, const int* in_sizes, int n_in, void* d_out, int out_size, void* d_ws, size_t ws_size, hipStream_t stream) {
    static int grid = 0;
    if (grid == 0) {
        if (n_in != N_IN || out_size != M_TOK * D_MODEL || ws_size < WS_END) { fprintf(stderr, "kernel_launch: unexpected shapes (n_in %d out %d ws %zu)\n", n_in, out_size, ws_size); grid = -1; return; }
        int dev = 0, cus = 0, per_cu = 0;
        if (hipGetDevice(&dev) != hipSuccess || hipDeviceGetAttribute(&cus, hipDeviceAttributeMultiprocessorCount, dev) != hipSuccess) { grid = -1; return; }
        if (hipFuncSetAttribute((const void*)mega_fwd, hipFuncAttributeMaxDynamicSharedMemorySize, LDS_BYTES) != hipSuccess) { fprintf(stderr, "kernel_launch: hipFuncSetAttribute failed\n"); grid = -1; return; }
        if (hipOccupancyMaxActiveBlocksPerMultiprocessor(&per_cu, (const void*)mega_fwd, NTHREADS, LDS_BYTES) != hipSuccess || per_cu < 1) { fprintf(stderr, "kernel_launch: occupancy query gave %d\n", per_cu); per_cu = 1; }
        (void)hipGetLastError();
        grid = cus;
    }
    if (grid < 0) return;
    if (hipMemsetAsync(d_ws, 0, 1u << 20, stream) != hipSuccess) { fprintf(stderr, "kernel_launch: memset of the control words failed\n"); return; }
    Args a{};
    for (int i = 0; i < N_IN; ++i) a.in[i] = (const float*)d_in[i];
    a.out = (float*)d_out; a.ws = (unsigned char*)d_ws;
#if MK_ONE_LAUNCH
    a.ph_lo = 0; a.ph_hi = N_PHASES;
    void* kargs[] = {&a};
    hipError_t e = hipLaunchCooperativeKernel((const void*)mega_fwd, dim3(grid), dim3(NTHREADS), kargs, LDS_BYTES, stream);
    if (e != hipSuccess) fprintf(stderr, "cooperative launch failed: %s (grid %d)\n", hipGetErrorString(e), grid);
#else
    for (int p = 0; p < N_PHASES; ++p) { a.ph_lo = p; a.ph_hi = p + 1; hipLaunchKernelGGL(mega_fwd, dim3(grid), dim3(NTHREADS), LDS_BYTES, stream, a); }
#endif
}
```
